# Optimizing an MI355X kernel written in HIP

```python
import jax, jax.numpy as jnp
from jax import lax
import numpy as np

D_MODEL = 1024
BATCH = 8
SEQ = 2048
DEPTH = 4
DEC_BATCH = 128
DEC_SEQ = 8
PAST_LEN = 16384
PAGE_SIZE = 128

D_MIX = D_MODEL
D_POOL = D_MIX // 2
D_RET = D_MIX - D_POOL
POOL_WINDOWS = (2, 4, 8, 16)
POOL_GROUPS = len(POOL_WINDOWS)
POOL_CG = D_POOL // POOL_GROUPS
POOL_BUF = max(POOL_WINDOWS) - 1
RET_HEADS = 4
RET_DK = D_RET // RET_HEADS
RET_DV = D_RET // RET_HEADS
RET_CHUNK = 128
ROPE_BASE = 10000.0
D_IN = D_POOL + 3 * D_RET + D_MIX
EPS = 1e-6

kernel_name = 'hymba_pool_retention_decode_step'


def _rmsnorm(x, g):
    xf = x.astype(jnp.float32)
    y = xf * lax.rsqrt(jnp.mean(xf * xf, axis=-1, keepdims=True) + EPS)
    if g is not None:
        y = y * g.astype(jnp.float32)
    return y.astype(x.dtype)


def _rope(x, pos):
    half = x.shape[-1] // 2
    inv = 1.0 / (ROPE_BASE ** (jnp.arange(half, dtype=jnp.float32) / half))
    ang = pos.astype(jnp.float32)[:, None] * inv[None, :]
    cos = jnp.cos(ang)[None, :, None, :]
    sin = jnp.sin(ang)[None, :, None, :]
    xf = x.astype(jnp.float32)
    x1, x2 = xf[..., :half], xf[..., half:]
    return jnp.concatenate([x1 * cos - x2 * sin, x1 * sin + x2 * cos], axis=-1)


def _log_gamma():
    h = jnp.arange(RET_HEADS, dtype=jnp.float32)
    return jnp.log(1.0 - jnp.exp2(-5.0 - h))


def _pool_mixer(u_full, n_new, w_pool, scale):
    B, Lf, _ = u_full.shape
    uf = u_full.astype(jnp.float32).reshape(B, Lf, POOL_GROUPS, POOL_CG)
    P = jnp.concatenate([jnp.zeros((B, 1, POOL_GROUPS, POOL_CG), jnp.float32),
                         jnp.cumsum(uf, axis=1)], axis=1)
    t = jnp.arange(Lf - n_new, Lf)
    outs = []
    for g, w in enumerate(POOL_WINDOWS):
        lo = jnp.maximum(t + 1 - w, 0)
        s = P[:, t + 1, g] - P[:, lo, g]
        cnt = (t + 1 - lo).astype(jnp.float32)[None, :, None]
        outs.append(s / cnt - uf[:, t, g])
    m = jnp.stack(outs, axis=2)
    y = jnp.einsum('bngc,gcd->bngd', m, w_pool.astype(jnp.float32))
    y = y.reshape(B, n_new, D_POOL) * scale.astype(jnp.float32)
    return y


def _retention(q, k, v, S0):
    B, L, H, DK = q.shape
    DV = v.shape[-1]
    C = RET_CHUNK if L % RET_CHUNK == 0 else L
    n = L // C
    lg = _log_gamma()
    qc = q.reshape(B, n, C, H, DK)
    kc = k.reshape(B, n, C, H, DK)
    vc = v.astype(jnp.float32).reshape(B, n, C, H, DV)
    idx = jnp.arange(C)
    diff = idx[:, None] - idx[None, :]
    dmask = jnp.where((diff >= 0)[:, :, None],
                      jnp.exp(jnp.maximum(diff, 0).astype(jnp.float32)[:, :, None] * lg), 0.0)
    scores = jnp.einsum('bnihd,bnjhd->bnhij', qc, kc) * jnp.transpose(dmask, (2, 0, 1))
    intra = jnp.einsum('bnhij,bnjhe->bnihe', scores, vc)
    kdec = jnp.exp((C - 1 - idx).astype(jnp.float32)[:, None] * lg)
    kv = jnp.einsum('bnjhd,jh,bnjhe->bnhde', kc, kdec, vc)
    gC = jnp.exp(C * lg)

    def step(S, kv_c):
        return gC[None, :, None, None] * S + kv_c, S

    S_fin, S_prev = lax.scan(step, S0.astype(jnp.float32), jnp.moveaxis(kv, 1, 0))
    S_prev = jnp.moveaxis(S_prev, 0, 1)
    qdec = jnp.exp((idx + 1).astype(jnp.float32)[:, None] * lg)
    cross = jnp.einsum('bnihd,ih,bnhde->bnihe', qc, qdec, S_prev)
    o = (intra + cross).reshape(B, L, H, DV)
    return o, S_fin


def _layer(x, c, pos, S0, pool_buf, w_ada, b_ada, g_pre, g_post, w_in, w_pool, pool_scale, w_o):
    B, L, _ = x.shape
    mod = jax.nn.silu(c.astype(jnp.float32)) @ w_ada.astype(jnp.float32) + b_ada.astype(jnp.float32)
    shift, scl, gate_res = jnp.split(mod, 3, axis=-1)
    h = _rmsnorm(x, g_pre).astype(jnp.float32) * (1.0 + scl[:, None]) + shift[:, None]
    z = (h.astype(x.dtype) @ w_in).astype(jnp.float32)
    o1 = D_POOL
    o2 = o1 + D_RET
    o3 = o2 + D_RET
    o4 = o3 + D_RET
    u, q, k, v, gate = z[..., :o1], z[..., o1:o2], z[..., o2:o3], z[..., o3:o4], z[..., o4:]
    if pool_buf is None:
        u_full = u
    else:
        u_full = jnp.concatenate([pool_buf.astype(jnp.float32), u], axis=1)
    pool_out = _pool_mixer(u_full, L, w_pool, pool_scale)
    new_buf = u_full[:, -POOL_BUF:]
    q = _rope(q.reshape(B, L, RET_HEADS, RET_DK), pos)
    k = _rope(k.reshape(B, L, RET_HEADS, RET_DK), pos) * (RET_DK ** -0.5)
    v = v.reshape(B, L, RET_HEADS, RET_DV)
    o, S_new = _retention(q, k, v, S0)
    o = _rmsnorm(o, None).reshape(B, L, D_RET)
    mix = jnp.concatenate([pool_out, o], axis=-1) * jax.nn.silu(gate)
    y = mix.astype(x.dtype) @ w_o
    y = _rmsnorm(y, g_post).astype(jnp.float32)
    x_out = (x.astype(jnp.float32) + gate_res[:, None] * y).astype(x.dtype)
    return x_out, S_new, new_buf


def setup_inputs(seed: int = 0) -> dict:
    key = jax.random.key(seed)
    ks = jax.random.split(key, 16)
    f = jnp.float32
    x_prompt = jax.random.normal(ks[0], (BATCH, SEQ, D_MODEL), f)
    x_sample = jax.random.normal(ks[1], (DEC_BATCH, DEC_SEQ, D_MODEL), f)
    c_prompt = jax.random.normal(ks[2], (BATCH, D_MODEL), f)
    c_sample = jax.random.normal(ks[3], (DEC_BATCH, D_MODEL), f)
    state_ret = 0.1 * jax.random.normal(ks[4], (DEPTH, DEC_BATCH, RET_HEADS, RET_DK, RET_DV), f)
    state_pool = jax.random.normal(ks[5], (DEPTH, DEC_BATCH, POOL_BUF, D_POOL), f)
    w_ada = 0.5 * D_MODEL ** -0.5 * jax.random.normal(ks[6], (DEPTH, D_MODEL, 3 * D_MODEL), f)
    b_ada = 0.02 * jax.random.normal(ks[7], (DEPTH, 3 * D_MODEL), f)
    g_pre = 1.0 + 0.05 * jax.random.normal(ks[8], (DEPTH, D_MODEL), f)
    g_post = 1.0 + 0.05 * jax.random.normal(ks[9], (DEPTH, D_MODEL), f)
    w_in = D_MODEL ** -0.5 * jax.random.normal(ks[10], (DEPTH, D_MODEL, D_IN), f)
    w_pool = POOL_CG ** -0.5 * jax.random.normal(ks[11], (DEPTH, POOL_GROUPS, POOL_CG, POOL_CG), f)
    pool_scale = 1.0 + 0.1 * jax.random.normal(ks[12], (DEPTH, D_POOL), f)
    w_o = D_MIX ** -0.5 * jax.random.normal(ks[13], (DEPTH, D_MIX, D_MODEL), f)
    return {'x_prompt': x_prompt, 'x_sample': x_sample, 'c_prompt': c_prompt, 'c_sample': c_sample,
            'state_ret': state_ret, 'state_pool': state_pool, 'w_ada': w_ada, 'b_ada': b_ada,
            'g_pre': g_pre, 'g_post': g_post, 'w_in': w_in, 'w_pool': w_pool,
            'pool_scale': pool_scale, 'w_o': w_o}


def reference(x_prompt, x_sample, c_prompt, c_sample, state_ret, state_pool, w_ada, b_ada,
              g_pre, g_post, w_in, w_pool, pool_scale, w_o):
    pos_p = jnp.arange(x_prompt.shape[1])
    pos_s = PAST_LEN + jnp.arange(x_sample.shape[1])
    Bp = x_prompt.shape[0]
    hp, hs = x_prompt, x_sample
    ret_p, pool_p, ret_s, pool_s = [], [], [], []
    for l in range(DEPTH):
        S0 = jnp.zeros((Bp, RET_HEADS, RET_DK, RET_DV), jnp.float32)
        hp, Sp, bp = _layer(hp, c_prompt, pos_p, S0, None, w_ada[l], b_ada[l], g_pre[l], g_post[l],
                            w_in[l], w_pool[l], pool_scale[l], w_o[l])
        hs, Ss, bs = _layer(hs, c_sample, pos_s, state_ret[l], state_pool[l], w_ada[l], b_ada[l],
                            g_pre[l], g_post[l], w_in[l], w_pool[l], pool_scale[l], w_o[l])
        ret_p.append(Sp.astype(x_prompt.dtype))
        pool_p.append(bp.astype(x_prompt.dtype))
        ret_s.append(Ss.astype(state_ret.dtype))
        pool_s.append(bs.astype(state_pool.dtype))
    ret_prompt = jnp.stack(ret_p, axis=0)
    pool_prompt = jnp.stack(pool_p, axis=0)
    ret_sample = jnp.stack(ret_s, axis=0)
    pool_sample = jnp.stack(pool_s, axis=0)
    return (hp, hs, ret_prompt, pool_prompt, ret_sample, pool_sample)
```

```cpp
#include <hip/hip_runtime.h>
#include <hip/hip_cooperative_groups.h>
#include <cstdio>
#include <cstdint>
namespace cg = cooperative_groups;

#define LAS __attribute__((address_space(3)))
typedef unsigned short bf16_t;
typedef short bf16x8 __attribute__((ext_vector_type(8)));
typedef float f32x4 __attribute__((ext_vector_type(4)));
typedef unsigned u32x4 __attribute__((ext_vector_type(4)));
typedef unsigned u32x2 __attribute__((ext_vector_type(2)));

constexpr int DM = 1024, NP = 16384, NS = 1024, NTOK = NP + NS, DIN = 3072, DEPTH = 4;
constexpr int LP = 2048, NB = 8, SB = 128, SL = 8;
constexpr int MODLD = DEPTH * 3 * DM;
constexpr float EPSN = 1e-6f;

__device__ __forceinline__ bf16_t f2bf(float f) { unsigned u = __float_as_uint(f); u += 0x7FFFu + ((u >> 16) & 1u); return (bf16_t)(u >> 16); }
__device__ __forceinline__ float bf2f(bf16_t b) { return __uint_as_float(((unsigned)b) << 16); }
__device__ __forceinline__ unsigned cvt_pk_bf16(float lo, float hi) { unsigned r; asm volatile("v_cvt_pk_bf16_f32 %0, %1, %2" : "=v"(r) : "v"(lo), "v"(hi)); return r; }
__device__ __forceinline__ float silu_f(float x) { return x * __builtin_amdgcn_rcpf(1.0f + __builtin_amdgcn_exp2f(-1.4426950408889634f * x)); }
__device__ __forceinline__ float fexp2(float x) { return __builtin_amdgcn_exp2f(x); }
__device__ __forceinline__ float lg2gamma(int h) { return log2f(1.0f - exp2f(-5.0f - (float)h)); }
__device__ __forceinline__ float wave_sum(float v) {
#pragma unroll
    for (int o = 32; o >= 1; o >>= 1) v += __shfl_xor(v, o);
    return v;
}

#define GAS __attribute__((address_space(1)))
__device__ __forceinline__ unsigned char* ows(unsigned char* w) { GAS unsigned char* g = (GAS unsigned char*)w; asm volatile("" : "+s"(g)); return (unsigned char*)g; }
template <class T> __device__ __forceinline__ T* as_global(T* q) { GAS T* g = (GAS T*)q; asm volatile("" : "+s"(g)); return (T*)g; }
__device__ __forceinline__ int otid() { int t = (int)threadIdx.x; asm volatile("" : "+v"(t)); return t; }

constexpr size_t al256(size_t x) { return (x + 255) & ~(size_t)255; }
constexpr size_t WS_WIN = 0;
constexpr size_t WS_WO = WS_WIN + al256((size_t)DEPTH * DIN * DM * 2);
constexpr size_t WS_WADA = WS_WO + al256((size_t)DEPTH * DM * DM * 2);
constexpr size_t WS_WPOOL = WS_WADA + al256((size_t)DEPTH * DIN * DM * 2);
constexpr size_t WS_SC = WS_WPOOL + al256((size_t)DEPTH * 4 * 128 * 128 * 2);
constexpr size_t WS_MOD = WS_SC + al256((size_t)256 * DM * 2);
constexpr size_t WS_COS = WS_MOD + al256((size_t)256 * MODLD * 4);
constexpr size_t WS_SIN = WS_COS + al256((size_t)2056 * 64 * 4);
constexpr size_t WS_H = WS_SIN + al256((size_t)2056 * 64 * 4);
constexpr size_t WS_ZB = WS_H + al256((size_t)NTOK * DM * 2);
constexpr size_t WS_KTD = WS_ZB + al256((size_t)NTOK * DIN * 2);
constexpr size_t WS_VT = WS_KTD + al256((size_t)NB * 4 * 128 * LP * 2);
constexpr size_t WS_SPT = WS_VT + al256((size_t)NB * 4 * 128 * LP * 2);
constexpr size_t WS_MIX = WS_SPT + al256((size_t)NB * 16 * 4 * 128 * 128 * 2);
constexpr size_t WS_Y = WS_MIX + al256((size_t)NTOK * DM * 2);
constexpr size_t WS_WINF = WS_Y;
constexpr size_t WS_HSF = WS_Y + ((size_t)32 << 20);
constexpr size_t WS_XR = WS_Y + al256((size_t)NTOK * DM * 4);
constexpr size_t WS_QF = WS_XR + al256((size_t)NTOK * DM * 4);
constexpr size_t WS_KF = WS_QF + al256((size_t)NP * 512 * 2);
constexpr size_t WS_G2 = WS_KF + al256((size_t)NP * 512 * 2);
constexpr size_t WS_BAR = WS_G2 + al256((size_t)NP * DM * 2);
constexpr size_t WS_END = WS_BAR + al256((size_t)3456 * 4);


__device__ __forceinline__ size_t mixf_index(size_t row, int col) { return ((size_t)((row >> 4) * 32 + (col >> 5)) * 64 + (((col >> 3) & 3) * 16 + (row & 15))) * 8 + (col & 7); }
__device__ __forceinline__ size_t g2_index(size_t row, int gc) { return ((size_t)((row >> 4) * 64 + (gc >> 4)) * 64 + (((gc >> 2) & 3) * 16 + (row & 15))) * 4 + (gc & 3); }

__device__ __forceinline__ size_t pf_index(int b, int h, int t, int e) {
    return ((size_t)((((b * 4 + h) * 16 + (t >> 7)) * 4 + ((t >> 5) & 3)) * 128 + e)) * 32 + (((t & 15) >> 2) * 8) + (((t >> 4) & 1) * 4) + (t & 3);
}

namespace pg8 {
constexpr int BM = 256, BK = 64, HALF = 128, HTB = HALF * BK * 2, STAGE_BYTES = 8 * HTB, NXCD = 8, WGM = 8;
__host__ __device__ __forceinline__ int lds_byte(int r, int c) { const int st = (r >> 4) * 2 + (c >> 5), rr = r & 15, cc = c & 31, ob = rr * 64 + cc * 2; return st * 1024 + (ob ^ (((ob >> 9) & 1) << 5)); }
__host__ __device__ __forceinline__ void stage_rc(int b, int& R, int& C) { const int st = b / 1024, sb = b % 1024, swz = sb ^ (((sb >> 9) & 1) << 5); R = (st >> 1) * 16 + swz / 64; C = (st & 1) * 32 + (swz % 64) / 2; }
struct Unit { int pm, pn; };
struct Gemm { const bf16_t* A; const bf16_t* Bt; int M, N, K; };
struct StaticOrder {
    int nM, nN, nwg, G, c;
    __host__ __device__ void init(int M, int N, int G_, int c_) { nM = M / BM; nN = N / BM; nwg = nM * nN; G = G_; c = c_; }
    __host__ __device__ bool next(int i, Unit& u) const {
        const long L = (long)i * G + c; if (L >= nwg) return false;
        int wgid = (int)L; { const int q = nwg / NXCD, r = nwg % NXCD, xcd = wgid % NXCD, off = wgid / NXCD; wgid = (xcd < r ? xcd * (q + 1) : r * (q + 1) + (xcd - r) * q) + off; }
        const int nig = WGM * nN, gid = wgid / nig, fm = gid * WGM, gsz = (nM - fm) < WGM ? (nM - fm) : WGM;
        u.pm = fm + ((wgid % nig) % gsz); u.pn = (wgid % nig) / gsz; return true;
    }
    __device__ __forceinline__ void a_ready(const Unit&) const {}
    __device__ __forceinline__ void done(const Unit&) const {}
};

struct EpiF32 {
    __host__ __device__ static __forceinline__ int bperm(int R) { return R; }
    float* C; int ldc; const float* bias;
    __device__ __forceinline__ void operator()(const f32x4 (&acc)[2][2][4][2], const Unit& u, int wr, int wc, int fr, int fq) const {
        const int row0 = u.pm * BM + wr * 64 + fr, col0 = u.pn * BM + wc * 32 + 4 * fq;
        f32x4 bv[2][2];
#pragma unroll
        for (int bj = 0; bj < 2; ++bj)
#pragma unroll
            for (int n = 0; n < 2; ++n) bv[bj][n] = bias ? *(const f32x4*)(bias + col0 + bj * HALF + n * 16) : (f32x4){0.f, 0.f, 0.f, 0.f};
#pragma unroll
        for (int ai = 0; ai < 2; ++ai)
#pragma unroll
            for (int m = 0; m < 4; ++m) { float* rowp = C + (size_t)(row0 + ai * HALF + m * 16) * ldc + col0;
#pragma unroll
                for (int bj = 0; bj < 2; ++bj)
#pragma unroll
                    for (int n = 0; n < 2; ++n) *(f32x4*)(rowp + bj * HALF + n * 16) = acc[ai][bj][m][n] + bv[bj][n]; }
    }
};

struct EpiZ {
    __host__ __device__ static __forceinline__ int bperm(int R) { return 64 * ((R >> 4) & 1) + 16 * (R >> 5) + (R & 15); }
    unsigned char* ws; float* poolP; float* poolS;
    __device__ __forceinline__ void operator()(const f32x4 (&acc)[2][2][4][2], const Unit& u, int wr, int wc, int fr, int fq) const {
        const int pn = u.pn; const bool prompt = u.pm < 64;
        unsigned char* const wsg = as_global(ws); float* const poolPg = as_global(poolP); float* const poolSg = as_global(poolS);
        bf16_t* const ZB = (bf16_t*)(wsg + WS_ZB); bf16_t* const KTD = (bf16_t*)(wsg + WS_KTD); bf16_t* const VT = (bf16_t*)(wsg + WS_VT); bf16_t* const QF = (bf16_t*)(wsg + WS_QF); bf16_t* const KF = (bf16_t*)(wsg + WS_KF);
        const float* const cosT = (const float*)(wsg + WS_COS); const float* const sinT = (const float*)(wsg + WS_SIN);
        const int d0 = wc * 16 + 4 * fq;
#pragma unroll
        for (int ai = 0; ai < 2; ++ai)
#pragma unroll
            for (int m = 0; m < 4; ++m) {
                const int row = u.pm * BM + ai * HALF + wr * 64 + m * 16 + fr;
                const int tpos = prompt ? (row & 2047) : (2048 + (row & 7));
#pragma unroll
                for (int bj = 0; bj < 2; ++bj) {
                    f32x4 v0 = acc[ai][bj][m][0], v1 = acc[ai][bj][m][1];
                    const int colb = pn * BM + bj * HALF;
                    const int h = (pn & 1) * 2 + bj;
                    if (pn >= 2 && pn < 6) {
                        const f32x4 c4 = *(const f32x4*)(cosT + tpos * 64 + d0), s4 = *(const f32x4*)(sinT + tpos * 64 + d0);
                        f32x4 r0 = v0 * c4 - v1 * s4, r1 = v0 * s4 + v1 * c4;
                        if (pn >= 4) { r0 *= 0.08838834764831845f; r1 *= 0.08838834764831845f; }
                        v0 = r0; v1 = r1;
                    }
                    u32x2 w0, w1; w0.x = cvt_pk_bf16(v0[0], v0[1]); w0.y = cvt_pk_bf16(v0[2], v0[3]); w1.x = cvt_pk_bf16(v1[0], v1[1]); w1.y = cvt_pk_bf16(v1[2], v1[3]);
                    if (prompt && pn >= 2 && pn < 6) {
                        bf16_t* fp = (pn < 4 ? QF : KF) + ((size_t)((((row >> 4) * 4 + h) * 4 + (wc >> 1)) * 64 + (((2 * wc + (fq >> 1)) & 3) * 16 + fr))) * 8 + 4 * (fq & 1);
                        *(u32x2*)fp = w0; *(u32x2*)(fp + 2 * 512) = w1;
                    } else if (prompt && pn >= 8) {
                        bf16_t* gp = (bf16_t*)(wsg + WS_G2) + g2_index((size_t)row, colb - 2048 + d0);
                        *(u32x2*)gp = w0; *(u32x2*)(gp + 4 * 64 * 4) = w1;
                    } else if (!(prompt && pn >= 6 && pn < 8)) {
                        bf16_t* zp = ZB + (size_t)row * DIN + colb + d0;
                        *(u32x2*)zp = w0; *(u32x2*)(zp + 64) = w1;
                    }
                    if (prompt && pn >= 4 && pn < 6) {
                        const int b = row >> 11, t = row & 2047;
                        const float dec = fexp2((float)(127 - (t & 127)) * lg2gamma(h));
                        bf16_t* kp = KTD + pf_index(b, h, t, d0);
#pragma unroll
                        for (int j = 0; j < 4; ++j) { kp[j * 32] = f2bf(v0[j] * dec); kp[(64 + j) * 32] = f2bf(v1[j] * dec); }
                    }
                    if (prompt && pn >= 6 && pn < 8) {
                        const int b = row >> 11, t = row & 2047;
                        bf16_t* vp = VT + pf_index(b, h, t, d0);
#pragma unroll
                        for (int j = 0; j < 4; ++j) { vp[j * 32] = f2bf(v0[j]); vp[(64 + j) * 32] = f2bf(v1[j]); }
                    }
                    if (pn < 2) {
                        if (prompt) { const int b = row >> 11, t = row & 2047;
                            if (t >= 2033) { float* pp = poolPg + ((size_t)(b * 15 + (t - 2033))) * 512 + colb + d0; *(f32x4*)pp = v0; *(f32x4*)(pp + 64) = v1; } }
                        else { const int sb = (row - NP) >> 3, ts = row & 7;
                            float* pp = poolSg + ((size_t)(sb * 15 + 7 + ts)) * 512 + colb + d0; *(f32x4*)pp = v0; *(f32x4*)(pp + 64) = v1; }
                    }
                }
                asm volatile("" ::: "memory");
            }
    }
};

template <class Epi, class Sched>
__device__ __forceinline__ void gemm_phase(LAS unsigned char* lds, const Gemm g, const Sched& S, const Epi& E) {
    const int tid = otid(), wid = __builtin_amdgcn_readfirstlane(tid >> 6), lane = tid & 63, wr = wid >> 2, wc = wid & 3, fr = lane & 15, fq = lane >> 4;
    const int K = g.K, nt = K / BK;
    unsigned voffA[2], voffB[2];
#pragma unroll
    for (int i = 0; i < 2; ++i) { int R, C; stage_rc(tid * 16 + i * 8192, R, C); const int Rb = Epi::bperm(R);
        voffA[i] = (unsigned)(R * K + C) * 2u; voffB[i] = (unsigned)(Rb * K + C) * 2u; }
    const size_t kstep = (size_t)(BK * 2);
    const size_t hstep = (size_t)HALF * K * 2;
    const size_t tstep = 2 * hstep;
    const unsigned ldsw = (unsigned)wid * 1024u;
    const int aoff = lds_byte(wr * 64 + fr, fq * 8), boff = lds_byte(wc * 32 + fr, fq * 8);
#define PG8_SA(b, h) (((b) * 2 + (h)) * HTB)
#define PG8_SB(b, h) ((4 + (b) * 2 + (h)) * HTB)
#define PG8_STAGE(bufoff, gbase, voff) do { _Pragma("unroll") for (int _i = 0; _i < 2; ++_i) \
        __builtin_amdgcn_global_load_lds((const unsigned*)((const char*)(gbase) + (voff)[_i]), (LAS unsigned*)(lds + (bufoff) + ldsw + _i * 8192), 16, 0, 0); } while (0)
#define PG8_LDA(dst, b, h) do { _Pragma("unroll") for (int m = 0; m < 4; ++m) _Pragma("unroll") for (int k = 0; k < 2; ++k) dst[m][k] = *(const LAS bf16x8*)(lds + PG8_SA(b, h) + aoff + m * 2048 + k * 1024); } while (0)
#define PG8_LDB(dst, b, h) do { _Pragma("unroll") for (int n = 0; n < 2; ++n) _Pragma("unroll") for (int k = 0; k < 2; ++k) dst[n][k] = *(const LAS bf16x8*)(lds + PG8_SB(b, h) + boff + n * 2048 + k * 1024); } while (0)
#define PG8_MMA(ai, bj, At, Bt) do { __builtin_amdgcn_s_setprio(1); _Pragma("unroll") for (int m = 0; m < 4; ++m) _Pragma("unroll") for (int n = 0; n < 2; ++n) _Pragma("unroll") for (int k = 0; k < 2; ++k) \
        acc[ai][bj][m][n] = __builtin_amdgcn_mfma_f32_16x16x32_bf16(Bt[n][k], At[m][k], acc[ai][bj][m][n], 0, 0, 0); __builtin_amdgcn_s_setprio(0); } while (0)
#define PG8_WAIT_V(n) asm volatile("s_waitcnt vmcnt(" #n ")" ::: "memory")
#define PG8_WAIT_L(n) asm volatile("s_waitcnt lgkmcnt(" #n ")" ::: "memory")
#define PG8_BAR __builtin_amdgcn_s_barrier()
#define PG8_SCHED __builtin_amdgcn_sched_barrier(0)
    Unit cur, nxt; int ui = 0;
    if (!S.next(0, cur)) return;
    f32x4 acc[2][2][4][2];
#pragma unroll
    for (int a = 0; a < 2; ++a)
#pragma unroll
        for (int b = 0; b < 2; ++b)
#pragma unroll
            for (int m = 0; m < 4; ++m)
#pragma unroll
                for (int n = 0; n < 2; ++n) acc[a][b][m][n] = (f32x4){0.f, 0.f, 0.f, 0.f};
    bf16x8 At[4][2], B0[2][2], B1[2][2];
    const char* cA = (const char*)g.A + (size_t)cur.pm * tstep; const char* cB = (const char*)g.Bt + (size_t)cur.pn * tstep;
    S.a_ready(cur);
    PG8_STAGE(PG8_SB(0, 0), cB, voffB); PG8_STAGE(PG8_SA(0, 0), cA, voffA); PG8_STAGE(PG8_SB(0, 1), cB + hstep, voffB); PG8_STAGE(PG8_SA(0, 1), cA + hstep, voffA);
    if (wr == 1) PG8_BAR;
    PG8_WAIT_V(4); PG8_BAR;
    PG8_STAGE(PG8_SB(1, 0), cB + kstep, voffB); PG8_STAGE(PG8_SA(1, 0), cA + kstep, voffA); PG8_STAGE(PG8_SB(1, 1), cB + hstep + kstep, voffB);
    PG8_WAIT_V(6); PG8_BAR;
    for (;;) {
        const bool has_next = S.next(ui + 1, nxt);
        const char* nA = has_next ? (const char*)g.A + (size_t)nxt.pm * tstep : cA; const char* nB = has_next ? (const char*)g.Bt + (size_t)nxt.pn * tstep : cB;
        for (int t = 0; t < nt; t += 2) {
            const bool last = (t == nt - 2);
            const char* a1 = cA + (size_t)(t + 1) * kstep;
            const char* a2 = last ? nA : cA + (size_t)(t + 2) * kstep; const char* b2 = last ? nB : cB + (size_t)(t + 2) * kstep;
            const char* a3 = a2 + kstep; const char* b3 = b2 + kstep;
            if (last && has_next) S.a_ready(nxt);
            PG8_LDB(B0, 0, 0); PG8_SCHED; PG8_LDA(At, 0, 0); PG8_STAGE(PG8_SA(1, 1), a1 + hstep, voffA);
            PG8_WAIT_L(8); PG8_BAR; PG8_WAIT_L(0); PG8_MMA(0, 0, At, B0); PG8_BAR; PG8_SCHED;
            PG8_LDB(B1, 0, 1); PG8_STAGE(PG8_SB(0, 0), b2, voffB);
            PG8_BAR; PG8_WAIT_L(0); PG8_MMA(0, 1, At, B1); PG8_BAR;
            PG8_LDA(At, 0, 1); PG8_STAGE(PG8_SA(0, 0), a2, voffA);
            PG8_BAR; PG8_WAIT_L(0); PG8_MMA(1, 0, At, B0); PG8_BAR; PG8_SCHED;
            PG8_STAGE(PG8_SB(0, 1), b2 + hstep, voffB);
            PG8_WAIT_V(6); PG8_BAR; PG8_MMA(1, 1, At, B1); PG8_BAR;
            PG8_LDB(B0, 1, 0); PG8_SCHED; PG8_LDA(At, 1, 0); PG8_STAGE(PG8_SA(0, 1), a2 + hstep, voffA);
            PG8_WAIT_L(8); PG8_BAR; PG8_WAIT_L(0); PG8_MMA(0, 0, At, B0); PG8_BAR; PG8_SCHED;
            PG8_LDB(B1, 1, 1); PG8_STAGE(PG8_SB(1, 0), b3, voffB);
            PG8_BAR; PG8_WAIT_L(0); PG8_MMA(0, 1, At, B1); PG8_BAR;
            PG8_LDA(At, 1, 1); PG8_STAGE(PG8_SA(1, 0), a3, voffA);
            PG8_BAR; PG8_WAIT_L(0); PG8_MMA(1, 0, At, B0); PG8_BAR; PG8_SCHED;
            PG8_STAGE(PG8_SB(1, 1), b3 + hstep, voffB);
            PG8_WAIT_V(6); PG8_BAR; PG8_MMA(1, 1, At, B1); PG8_BAR;
        }
        E(acc, cur, wr, wc, fr, fq); S.done(cur);
        if (!has_next) break;
#pragma unroll
        for (int a = 0; a < 2; ++a)
#pragma unroll
            for (int b = 0; b < 2; ++b)
#pragma unroll
                for (int m = 0; m < 4; ++m)
#pragma unroll
                    for (int n = 0; n < 2; ++n) acc[a][b][m][n] = (f32x4){0.f, 0.f, 0.f, 0.f};
        cur = nxt; cA = nA; cB = nB; ++ui;
    }
    PG8_WAIT_V(0);
    if (wr == 0) PG8_BAR;
    PG8_BAR;
#undef PG8_SA
#undef PG8_SB
#undef PG8_STAGE
#undef PG8_LDA
#undef PG8_LDB
#undef PG8_MMA
#undef PG8_WAIT_V
#undef PG8_WAIT_L
#undef PG8_BAR
#undef PG8_SCHED
}
}


#define XB_TMO      128
#define XB_XCNT(j)  (256  + 64 * (j))
#define XB_XSUB(j)  (1280 + 64 * (j))
#define XB_XGEN(j)  (2304 + 64 * (j))
#define XB_TOP      3328
#define XB_TOPGEN   3392
#define XCD_BAR_WORDS 3456
#define XB_SPIN_CAP (1u << 18)
__device__ __forceinline__ unsigned xb_ld(unsigned* p)              { return __hip_atomic_load(p, __ATOMIC_RELAXED, __HIP_MEMORY_SCOPE_AGENT); }
__device__ __forceinline__ unsigned xb_add(unsigned* p, unsigned v) { return __hip_atomic_fetch_add(p, v, __ATOMIC_RELAXED, __HIP_MEMORY_SCOPE_AGENT); }
__device__ __forceinline__ unsigned xb_xcc_id() { return (unsigned)__builtin_amdgcn_s_getreg((3 << 11) | 20) & 0xFu; }
#define XB_SPIN(cond, bar) do { unsigned _sp = 0; while (cond) { __builtin_amdgcn_s_sleep(1); \
    if ((++_sp & 255u) == 0u) { if (xb_ld(&(bar)[XB_TMO])) break; if (_sp > XB_SPIN_CAP) { atomicAdd(&(bar)[XB_TMO], 1u); break; } } } } while (0)
struct XcdBarrier { unsigned* bar; unsigned x; volatile LAS unsigned* st; };
__device__ __forceinline__ XcdBarrier xcd_barrier_post(unsigned* bar, volatile LAS unsigned* st) {
    XcdBarrier b; b.bar = bar; b.x = xb_xcc_id(); b.st = st;
    if (threadIdx.x == 0) (void)xb_add(&bar[XB_XCNT(b.x)], 1u);
    return b;
}
__device__ __forceinline__ void xcd_barrier_complete(unsigned* bar, unsigned x, unsigned& nloc, unsigned& nx) {
    const unsigned G = gridDim.x * gridDim.y * gridDim.z;
    unsigned sum, cnt, mine, sp = 0u;
    for (;;) {
        sum = 0u; cnt = 0u; mine = 0u;
#pragma unroll
        for (unsigned j = 0; j < 16; ++j) { const unsigned c = xb_ld(&bar[XB_XCNT(j)]); sum += c; cnt += (c > 0u) ? 1u : 0u; mine = (j == x) ? c : mine; }
        if (sum == G) break;
        __builtin_amdgcn_s_sleep(1);
        if ((++sp & 255u) == 0u) { if (xb_ld(&bar[XB_TMO])) break; if (sp > XB_SPIN_CAP) { atomicAdd(&bar[XB_TMO], 1u); break; } }
    }
    nloc = mine > 0u ? mine : 1u; nx = cnt > 0u ? cnt : 1u;
}
__device__ __forceinline__ void xcd_barrier(const XcdBarrier& b) {
    asm volatile("s_waitcnt vmcnt(0)" ::: "memory");
    __syncthreads();
    if (threadIdx.x == 0) {
        unsigned* bar = b.bar;
        __builtin_amdgcn_s_waitcnt(0);
        unsigned nloc = b.st[0], nx = b.st[1];
        if (nloc == 0u) { xcd_barrier_complete(bar, b.x, nloc, nx); b.st[0] = nloc; b.st[1] = nx; }
        const unsigned old = xb_add(&bar[XB_XSUB(b.x)], 1u);
        const unsigned gen = old / nloc;
        if (old + 1u == (gen + 1u) * nloc) {
            __builtin_amdgcn_fence(__ATOMIC_RELEASE, "agent");
            asm volatile("s_waitcnt vmcnt(0)" ::: "memory");
            const unsigned og = xb_add(&bar[XB_TOP], 1u);
            const unsigned tg = og / nx;
            if (og + 1u == (tg + 1u) * nx) xb_add(&bar[XB_TOPGEN], 1u);
            else XB_SPIN(xb_ld(&bar[XB_TOPGEN]) == tg, bar);
            __builtin_amdgcn_fence(__ATOMIC_ACQUIRE, "agent");
            xb_add(&bar[XB_XGEN(b.x)], 1u);
            asm volatile("s_waitcnt vmcnt(0)" ::: "memory");
        } else {
            XB_SPIN(xb_ld(&bar[XB_XGEN(b.x)]) == gen, bar);
            __builtin_amdgcn_fence(__ATOMIC_ACQUIRE, "agent");
            asm volatile("s_waitcnt vmcnt(0)" ::: "memory");
        }
    }
    __syncthreads();
}

struct Params {
    const float* x_prompt; const float* x_sample; const float* c_prompt; const float* c_sample;
    const float* state_ret; const float* state_pool; const float* w_ada; const float* b_ada;
    const float* g_pre; const float* g_post; const float* w_in; const float* w_pool; const float* pool_scale; const float* w_o;
    float* out; unsigned char* ws;
};
__device__ __forceinline__ Params gp(const Params& q) { return q; }
constexpr size_t OUT_YP = 0;
constexpr size_t OUT_YS = OUT_YP + (size_t)NP * DM;
constexpr size_t OUT_RETP = OUT_YS + (size_t)NS * DM;
constexpr size_t OUT_POOLP = OUT_RETP + (size_t)DEPTH * NB * 4 * 128 * 128;
constexpr size_t OUT_RETS = OUT_POOLP + (size_t)DEPTH * NB * 15 * 512;
constexpr size_t OUT_POOLS = OUT_RETS + (size_t)DEPTH * SB * 4 * 128 * 128;
constexpr size_t OUT_END = OUT_POOLS + (size_t)DEPTH * SB * 15 * 512;

constexpr int NTHREADS = 512;
constexpr int LDS_USER = 160 * 1024 - 16;
constexpr int LDS_BYTES = 160 * 1024;

struct TcTile { const float* src; bf16_t* dst; int R, C, tr, tc; bool frag; bf16_t* dst2; };
__device__ __forceinline__ TcTile tc_decode(const Params& p_, int t) {
    const Params p = gp(p_);
    unsigned char* const wsb = ows(p.ws);
    bf16_t* WinT = (bf16_t*)(wsb + WS_WIN); bf16_t* WoT = (bf16_t*)(wsb + WS_WO); bf16_t* WadaT = (bf16_t*)(wsb + WS_WADA); bf16_t* WpT = (bf16_t*)(wsb + WS_WPOOL);
    const int T1 = 3072, T2 = 6144, T3 = 7168;
    TcTile x;
    if (t < T1) { const int l = t / 768, r = t % 768; x = TcTile{p.w_in + (size_t)l * DM * DIN, WinT + (size_t)l * DIN * DM, DM, DIN, r / 48, r % 48, false, (bf16_t*)(wsb + WS_WINF) + (size_t)l * DIN * DM}; }
    else if (t < T2) { const int q = t - T1, l = q / 768, r = q % 768; x = TcTile{p.w_ada + (size_t)l * DM * DIN, WadaT + (size_t)l * DIN * DM, DM, DIN, r / 48, r % 48, false, nullptr}; }
    else if (t < T3) { const int q = t - T2, l = q / 256, r = q % 256; x = TcTile{p.w_o + (size_t)l * DM * DM, WoT + (size_t)l * DM * DM, DM, DM, r / 16, r % 16, true, nullptr}; }
    else { const int q = t - T3, m = q / 4, r = q % 4; x = TcTile{p.w_pool + (size_t)m * 128 * 128, WpT + (size_t)m * 128 * 128, 128, 128, r / 2, r % 2, false, nullptr}; }
    return x;
}

__device__ void phase_prep(const Params& p_, LAS unsigned char* lds) {
    const Params p = gp(p_);
    unsigned char* const wsb = ows(p.ws);
    LAS float* tile = (LAS float*)lds;
    const int tid = otid();
    const int T4 = 7232;
    for (int t0 = blockIdx.x * 4; t0 < T4; t0 += gridDim.x * 4) {
        f32x4 va[4], vb[4];
        const int r = tid >> 3, c0 = (tid & 7) * 8;
#pragma unroll
        for (int q = 0; q < 4; ++q) { const TcTile x = tc_decode(p, t0 + q);
            const float* sp = x.src + (size_t)(x.tr * 64 + r) * x.C + x.tc * 64 + c0;
            va[q] = __builtin_nontemporal_load((const f32x4*)sp); vb[q] = __builtin_nontemporal_load((const f32x4*)(sp + 4)); }
#pragma unroll
        for (int q = 0; q < 4; ++q) { LAS float* tl = tile + q * 64 * 65;
#pragma unroll
            for (int k = 0; k < 4; ++k) { tl[(c0 + k) * 65 + r] = va[q][k]; tl[(c0 + 4 + k) * 65 + r] = vb[q][k]; } }
        __syncthreads();
#pragma unroll
        for (int q = 0; q < 4; ++q) { const TcTile x = tc_decode(p, t0 + q); LAS float* tl = tile + q * 64 * 65;
            const int cc = tid >> 3, r8 = (tid & 7) * 8;
            u32x4 wv;
            wv.x = cvt_pk_bf16(tl[cc * 65 + r8 + 0], tl[cc * 65 + r8 + 1]); wv.y = cvt_pk_bf16(tl[cc * 65 + r8 + 2], tl[cc * 65 + r8 + 3]);
            wv.z = cvt_pk_bf16(tl[cc * 65 + r8 + 4], tl[cc * 65 + r8 + 5]); wv.w = cvt_pk_bf16(tl[cc * 65 + r8 + 6], tl[cc * 65 + r8 + 7]);
            const int n = x.tc * 64 + cc, k = x.tr * 64 + r8;
            const size_t di = x.frag ? ((size_t)(((n >> 4) * 32 + (k >> 5)) * 64 + (((k >> 3) & 3) * 16 + (n & 15)))) * 8 : (size_t)n * x.R + k;
            *(u32x4*)(x.dst + di) = wv;
            if (x.dst2) *(u32x4*)(x.dst2 + ((size_t)(((n >> 4) * 32 + (k >> 5)) * 64 + (((k >> 3) & 3) * 16 + (n & 15)))) * 8) = wv; }
        __syncthreads();
    }
    const int gtid = blockIdx.x * NTHREADS + otid(), gn = gridDim.x * NTHREADS;
    bf16_t* SC = (bf16_t*)(wsb + WS_SC);
    for (int i = gtid; i < 256 * DM; i += gn) { const int r = i >> 10, k = i & 1023;
        float v = 0.f; if (r < NB) v = silu_f(p.c_prompt[r * DM + k]); else if (r < NB + SB) v = silu_f(p.c_sample[(r - NB) * DM + k]);
        SC[i] = f2bf(v); }
    float* cosT = (float*)(wsb + WS_COS); float* sinT = (float*)(wsb + WS_SIN);
    for (int i = gtid; i < 2056 * 64; i += gn) { const int tp = i >> 6, f = i & 63;
        const float pos = (float)(tp < 2048 ? tp : (16384 + tp - 2048));
        const float inv = 1.0f / powf(10000.0f, (float)f * (1.0f / 64.0f));
        const float ang = pos * inv;
        const double a = (double)ang; const double kq = rint(a * 0.63661977236758134308); const double r = a - kq * 1.57079632679489661923;
        const double r2 = r * r;
        const double sn = r * (1.0 + r2 * (-1.0 / 6 + r2 * (1.0 / 120 + r2 * (-1.0 / 5040 + r2 * (1.0 / 362880 + r2 * (-1.0 / 39916800))))));
        const double cs = 1.0 + r2 * (-0.5 + r2 * (1.0 / 24 + r2 * (-1.0 / 720 + r2 * (1.0 / 40320 + r2 * (-1.0 / 3628800 + r2 * (1.0 / 479001600))))));
        const int qd = ((int)(long long)kq) & 3;
        double c, s; if (qd == 0) { c = cs; s = sn; } else if (qd == 1) { c = -sn; s = cs; } else if (qd == 2) { c = -cs; s = -sn; } else { c = sn; s = -cs; }
        cosT[i] = (float)c; sinT[i] = (float)s; }
}

__device__ void phase_rows(const Params& p_, int l_prev, int l_next, int row_lo, int row_hi) {
    const Params p = gp(p_);
    unsigned char* const wsb = ows(p.ws);
    const int tid0 = otid(); const int wave = tid0 >> 6, lane = tid0 & 63;
    const float* mod = (const float*)(wsb + WS_MOD); const float* Y = (const float*)(wsb + WS_Y);
    float* XR = (float*)(wsb + WS_XR); bf16_t* H = (bf16_t*)(wsb + WS_H);
    for (int row = row_lo + blockIdx.x * 8 + wave; row < row_hi; row += gridDim.x * 8) {
        const int brow = row < NP ? (row >> 11) : (NB + ((row - NP) >> 3));
        const float* xin = (l_prev <= 0) ? (row < NP ? p.x_prompt + (size_t)row * DM : p.x_sample + (size_t)(row - NP) * DM) : XR + (size_t)row * DM;
        f32x4 x[4];
#pragma unroll
        for (int j = 0; j < 4; ++j) x[j] = __builtin_nontemporal_load((const f32x4*)(xin + lane * 4 + j * 256));
        if (l_prev >= 0) {
            f32x4 y[4]; float ss = 0.f;
#pragma unroll
            for (int j = 0; j < 4; ++j) { y[j] = __builtin_nontemporal_load((const f32x4*)(Y + (size_t)row * DM + lane * 4 + j * 256)); ss += y[j][0] * y[j][0] + y[j][1] * y[j][1] + y[j][2] * y[j][2] + y[j][3] * y[j][3]; }
            ss = wave_sum(ss); const float rstd = rsqrtf(ss * (1.0f / DM) + EPSN);
            float* xo = (l_prev == DEPTH - 1) ? p.out + (size_t)row * DM : XR + (size_t)row * DM;
#pragma unroll
            for (int j = 0; j < 4; ++j) { const int col = lane * 4 + j * 256;
                const f32x4 gr = *(const f32x4*)(mod + (size_t)brow * MODLD + l_prev * 3072 + 2048 + col), gp = *(const f32x4*)(p.g_post + l_prev * DM + col);
                x[j] = x[j] + gr * (y[j] * rstd * gp); *(f32x4*)(xo + col) = x[j]; }
        }
        if (l_next < DEPTH) {
            float ss = 0.f;
#pragma unroll
            for (int j = 0; j < 4; ++j) ss += x[j][0] * x[j][0] + x[j][1] * x[j][1] + x[j][2] * x[j][2] + x[j][3] * x[j][3];
            ss = wave_sum(ss); const float rstd = rsqrtf(ss * (1.0f / DM) + EPSN);
#pragma unroll
            for (int j = 0; j < 4; ++j) { const int col = lane * 4 + j * 256;
                const f32x4 sh = *(const f32x4*)(mod + (size_t)brow * MODLD + l_next * 3072 + col), sc = *(const f32x4*)(mod + (size_t)brow * MODLD + l_next * 3072 + 1024 + col), gp = *(const f32x4*)(p.g_pre + l_next * DM + col);
                const f32x4 hv = x[j] * rstd * gp * (1.0f + sc) + sh;
                u32x2 w; w.x = cvt_pk_bf16(hv[0], hv[1]); w.y = cvt_pk_bf16(hv[2], hv[3]);
                if (row < NP) *(u32x2*)(H + (size_t)row * DM + col) = w;
                else *(u32x2*)((bf16_t*)(wsb + WS_HSF) + mixf_index((size_t)(row - NP), col)) = w; }
        }
    }
}

__device__ void kvscan_task(const Params& p_, int l, int task, LAS unsigned char* lds) {
    const Params p = gp(p_);
    unsigned char* const wsb = ows(p.ws);
    const int tid0 = otid(); const int wave = __builtin_amdgcn_readfirstlane(tid0 >> 6), lane = tid0 & 63, q4 = lane >> 4, lr = lane & 15;
    const int bh = task >> 3, es = task & 7, h = bh & 3, b = bh >> 2;
    const bf16_t* KTD = (const bf16_t*)(wsb + WS_KTD); const bf16_t* VT = (const bf16_t*)(wsb + WS_VT); bf16_t* SPT = (bf16_t*)(wsb + WS_SPT);
    const bf16_t* ka = KTD + (size_t)bh * 16 * 4 * 128 * 32 + (16 * wave + lr) * 32 + 8 * q4;
    const float g128 = fexp2(128.0f * lg2gamma(h));
    f32x4 S = {0.f, 0.f, 0.f, 0.f};
    const int e = 16 * es + lr, d0 = 16 * wave + 4 * q4;
    {
        u32x4 vv[8];
#pragma unroll
        for (int k = 0; k < 8; ++k) { const int pi = tid0 + k * NTHREADS; vv[k] = *(const u32x4*)(VT + (size_t)bh * 16 * 4 * 128 * 32 + (size_t)(pi >> 6) * 4096 + es * 512 + (pi & 63) * 8); }
#pragma unroll
        for (int k = 0; k < 8; ++k) { const int pi = tid0 + k * NTHREADS; *(LAS u32x4*)(lds + pi * 16) = vv[k]; }
        __syncthreads();
    }
    bf16x8 fa[2][4], fb[2][4];
#define KV_LOAD(s_, n_) do { _Pragma("unroll") for (int ks = 0; ks < 4; ++ks) { fa[s_][ks] = *(const bf16x8*)(ka + ((n_) * 4 + ks) * 4096); fb[s_][ks] = *(const LAS bf16x8*)(lds + ((n_) * 4 + ks) * 1024 + (lr * 4 + q4) * 16); } } while (0)
#define KV_STEP(s_, n_) do { f32x4 kv = {0.f, 0.f, 0.f, 0.f}; \
        _Pragma("unroll") for (int ks = 0; ks < 4; ++ks) kv = __builtin_amdgcn_mfma_f32_16x16x32_bf16(fa[s_][ks], fb[s_][ks], kv, 0, 0, 0); \
        u32x2 wv; wv.x = cvt_pk_bf16(S[0], S[1]); wv.y = cvt_pk_bf16(S[2], S[3]); \
        *(u32x2*)(SPT + ((size_t)((((((b * 16 + (n_)) * 4 + h) * 8 + es) * 4 + (wave >> 1)) * 64) + (((2 * wave + (q4 >> 1)) & 3) * 16 + lr))) * 8 + 4 * (q4 & 1)) = wv; \
        S = S * g128 + kv; } while (0)
    KV_LOAD(0, 0);
#pragma unroll
    for (int n = 0; n < 16; n += 2) {
        KV_LOAD(1, n + 1);
        __builtin_amdgcn_sched_barrier(0);
        KV_STEP(0, n);
        __builtin_amdgcn_sched_barrier(0);
        if (n + 2 < 16) KV_LOAD(0, n + 2);
        __builtin_amdgcn_sched_barrier(0);
        KV_STEP(1, n + 1);
        __builtin_amdgcn_sched_barrier(0);
    }
#undef KV_LOAD
#undef KV_STEP
    float* rp = p.out + OUT_RETP + ((size_t)((l * NB + b) * 4 + h)) * 16384;
#pragma unroll
    for (int r = 0; r < 4; ++r) rp[(d0 + r) * 128 + e] = S[r];
    __syncthreads();
}

__device__ void rs_task(const Params& p_, int l, int task, LAS unsigned char* lds) {
    const Params p = gp(p_);
    unsigned char* const wsb = ows(p.ws);
    const int tid = otid(), w = __builtin_amdgcn_readfirstlane(tid >> 6), lane = tid & 63, q4 = lane >> 4, lr = lane & 15, b = task >> 2, h = task & 3;
    const bf16_t* ZB = (const bf16_t*)(wsb + WS_ZB); bf16_t* MIX = (bf16_t*)(wsb + WS_MIX);
    LAS float* qT = (LAS float*)lds;
    LAS float* kT = qT + 1024;
    LAS float* kdT = kT + 1024;
    LAS float* vS = kdT + 1024;
    LAS float* sc = vS + 1024;
    LAS float* red = sc + 64;
    LAS float* uF = red + 16 * 8 * 128;
    LAS float* mS = uF + 23 * 128;
    const float lg = lg2gamma(h);
    const size_t r0 = (size_t)NP + b * 8;
    const int g = h, win = 2 << g;
    const float* S0 = p.state_ret + ((size_t)((l * SB + b) * 4 + h)) * 16384;
    float* S1 = p.out + OUT_RETS + ((size_t)((l * SB + b) * 4 + h)) * 16384;
    const int e4 = (tid & 31) * 4, dg = tid >> 5;
    f32x4 s0[8];
#pragma unroll
    for (int dd = 0; dd < 8; ++dd) s0[dd] = __builtin_nontemporal_load((const f32x4*)(S0 + (dg * 8 + dd) * 128 + e4));
    const int li = tid >> 6, ld2 = (tid & 63) * 2;
    const unsigned qv = __builtin_nontemporal_load((const unsigned*)(ZB + (r0 + li) * DIN + 512 + h * 128 + ld2)), kv = __builtin_nontemporal_load((const unsigned*)(ZB + (r0 + li) * DIN + 1024 + h * 128 + ld2)), vv = __builtin_nontemporal_load((const unsigned*)(ZB + (r0 + li) * DIN + 1536 + h * 128 + ld2));
    f32x4 hist = {0.f, 0.f, 0.f, 0.f}; u32x2 ucur = {0u, 0u};
    if (tid < 480) hist = __builtin_nontemporal_load((const f32x4*)(p.state_pool + ((size_t)(l * SB + b) * 15 + (tid >> 5)) * 512 + g * 128 + (tid & 31) * 4));
    if (tid < 256) ucur = *(const u32x2*)(ZB + (r0 + (tid >> 5)) * DIN + g * 128 + (tid & 31) * 4);
    const bf16_t gr0 = ZB[(r0 + li) * DIN + 2560 + h * 128 + lane], gr1 = ZB[(r0 + li) * DIN + 2560 + h * 128 + lane + 64];
    const bf16_t* WpT = (const bf16_t*)(wsb + WS_WPOOL) + (size_t)(l * 4 + g) * 16384;
    bf16x8 wf[4];
#pragma unroll
    for (int ks = 0; ks < 4; ++ks) wf[ks] = *(const bf16x8*)(WpT + (size_t)(16 * w + lr) * 128 + ks * 32 + 8 * q4);
    const int pcol = g * 128 + 16 * w + 4 * q4;
    const f32x4 psc = *(const f32x4*)(p.pool_scale + l * 512 + pcol);
    u32x2 gpq = {0u, 0u}; if (lr < 8) gpq = *(const u32x2*)(ZB + (r0 + lr) * DIN + 2048 + pcol);
    float cp[7];
    if (h == 0) {
#pragma unroll
        for (int k = 0; k < 7; ++k) cp[k] = p.state_pool[((size_t)(l * SB + b) * 15 + 8) * 512 + tid + k * NTHREADS];
    }
    __builtin_amdgcn_sched_barrier(0);
    { const float kd = fexp2((float)(7 - li) * lg);
      qT[ld2 * 8 + li] = __uint_as_float(qv << 16); qT[(ld2 + 1) * 8 + li] = __uint_as_float(qv & 0xffff0000u);
      const float k0 = __uint_as_float(kv << 16), k1 = __uint_as_float(kv & 0xffff0000u);
      kT[ld2 * 8 + li] = k0; kT[(ld2 + 1) * 8 + li] = k1; kdT[ld2 * 8 + li] = k0 * kd; kdT[(ld2 + 1) * 8 + li] = k1 * kd;
      vS[li * 128 + ld2] = __uint_as_float(vv << 16); vS[li * 128 + ld2 + 1] = __uint_as_float(vv & 0xffff0000u);
      if (tid < 480) *(LAS f32x4*)(uF + (tid >> 5) * 128 + (tid & 31) * 4) = hist;
      if (tid < 256) *(LAS f32x4*)(uF + (15 + (tid >> 5)) * 128 + (tid & 31) * 4) = (f32x4){__uint_as_float(ucur.x << 16), __uint_as_float(ucur.x & 0xffff0000u), __uint_as_float(ucur.y << 16), __uint_as_float(ucur.y & 0xffff0000u)};
      mS[1024 + tid] = 0.f; mS[1536 + tid] = 0.f; }
    __syncthreads();
    {
      const int pr = tid >> 3, i = pr >> 3, j = pr & 7, dp = tid & 7; float sv = 0.f;
#pragma unroll
      for (int d = dp * 16; d < dp * 16 + 16; ++d) sv += qT[d * 8 + i] * kT[d * 8 + j];
      sv += __shfl_xor(sv, 1); sv += __shfl_xor(sv, 2); sv += __shfl_xor(sv, 4);
      if (dp == 0) sc[pr] = (j <= i) ? sv * fexp2((float)(i - j) * lg) : 0.f; }
    {
      const int c = tid & 127, tq = tid >> 7; const float rw = 1.0f / (float)win;
#pragma unroll
      for (int k2 = 0; k2 < 2; ++k2) { const int ts = 2 * tq + k2; float sm = 0.f;
          for (int k = 0; k < win; ++k) sm += uF[(15 + ts - k) * 128 + c];
          mS[ts * 128 + c] = sm * rw - uF[(15 + ts) * 128 + c]; } }
    {
        const float g8 = fexp2(8.0f * lg);
        f32x4 cr[8], vj[8];
#pragma unroll
        for (int i = 0; i < 8; ++i) { cr[i] = (f32x4){0.f, 0.f, 0.f, 0.f}; vj[i] = *(const LAS f32x4*)(vS + i * 128 + e4); }
#pragma unroll
        for (int dd = 0; dd < 8; ++dd) { const int d = dg * 8 + dd;
            const f32x4 qa = *(const LAS f32x4*)(qT + d * 8), qb = *(const LAS f32x4*)(qT + d * 8 + 4), ka = *(const LAS f32x4*)(kdT + d * 8), kb = *(const LAS f32x4*)(kdT + d * 8 + 4);
            f32x4 sf = s0[dd] * g8;
#pragma unroll
            for (int i = 0; i < 4; ++i) { cr[i] += s0[dd] * qa[i]; cr[4 + i] += s0[dd] * qb[i]; sf += vj[i] * ka[i]; sf += vj[4 + i] * kb[i]; }
            __builtin_nontemporal_store(sf, (f32x4*)(S1 + d * 128 + e4)); }
#pragma unroll
        for (int i = 0; i < 8; ++i) *(LAS f32x4*)(red + (dg * 8 + i) * 128 + e4) = cr[i];
    }
    __syncthreads();
    { const int i = li; float o[2]; float ss = 0.f;
#pragma unroll
      for (int k = 0; k < 2; ++k) { const int e = lane + 64 * k;
          float cross = 0.f;
#pragma unroll
          for (int d2 = 0; d2 < 16; ++d2) cross += red[(d2 * 8 + i) * 128 + e];
          float v = fexp2((float)(i + 1) * lg) * cross;
#pragma unroll
          for (int j = 0; j < 8; ++j) v += sc[i * 8 + j] * vS[j * 128 + e];
          o[k] = v; ss += v * v; }
      ss = wave_sum(ss); const float rstd = rsqrtf(ss * (1.0f / 128.0f) + EPSN);
      MIX[(r0 + i) * DM + 512 + h * 128 + lane] = f2bf(o[0] * rstd * silu_f(bf2f(gr0)));
      MIX[(r0 + i) * DM + 512 + h * 128 + lane + 64] = f2bf(o[1] * rstd * silu_f(bf2f(gr1))); }
    {
        f32x4 acc = {0.f, 0.f, 0.f, 0.f};
#pragma unroll
        for (int ks = 0; ks < 4; ++ks) { const f32x4 m0 = *(const LAS f32x4*)(mS + lr * 128 + ks * 32 + 8 * q4), m1 = *(const LAS f32x4*)(mS + lr * 128 + ks * 32 + 8 * q4 + 4);
            const bf16x8 mf = __builtin_bit_cast(bf16x8, (u32x4){cvt_pk_bf16(m0[0], m0[1]), cvt_pk_bf16(m0[2], m0[3]), cvt_pk_bf16(m1[0], m1[1]), cvt_pk_bf16(m1[2], m1[3])});
            acc = __builtin_amdgcn_mfma_f32_16x16x32_bf16(wf[ks], mf, acc, 0, 0, 0); }
        if (lr < 8) { const float g0 = __uint_as_float(gpq.x << 16), g1 = __uint_as_float(gpq.x & 0xffff0000u), g2 = __uint_as_float(gpq.y << 16), g3 = __uint_as_float(gpq.y & 0xffff0000u);
            u32x2 o; o.x = cvt_pk_bf16(acc[0] * psc[0] * silu_f(g0), acc[1] * psc[1] * silu_f(g1)); o.y = cvt_pk_bf16(acc[2] * psc[2] * silu_f(g2), acc[3] * psc[3] * silu_f(g3));
            *(u32x2*)(MIX + (r0 + lr) * DM + pcol) = o; }
    }
    if (h == 0) {
        float* dp = p.out + OUT_POOLS + ((size_t)(l * SB + b) * 15) * 512;
#pragma unroll
        for (int k = 0; k < 7; ++k) dp[tid + k * NTHREADS] = cp[k];
    }
    __syncthreads();
}

template <int NPAIR>
__device__ __forceinline__ void retention_part(const Params& p_, int R0, int w, int q4, int lr, LAS unsigned char* lds, int tid) {
    const Params p = gp(p_);
    unsigned char* const wsb = ows(p.ws);
    const int lane = q4 * 16 + lr;
    const bf16_t* QF = (const bf16_t*)(wsb + WS_QF); const bf16_t* KF = (const bf16_t*)(wsb + WS_KF);
    const bf16_t* G2 = (const bf16_t*)(wsb + WS_G2); bf16_t* MIX = (bf16_t*)(wsb + WS_MIX);
    const bf16_t* VT = (const bf16_t*)(wsb + WS_VT); const bf16_t* SPT = (const bf16_t*)(wsb + WS_SPT);
    const int h = w >> 1, itb = 2 * (w & 1), b = R0 >> 11, n = (R0 & 2047) >> 7, itg0 = 4 * (NPAIR / 2 - 1) + itb;
    const size_t t0 = (size_t)(R0 & ~127);
    const float lg = lg2gamma(h);
    {
        const bf16_t* src = SPT + (size_t)((b * 16 + n) * 4) * 32 * 512;
#pragma unroll 1
        for (int k0 = 0; k0 < 16; k0 += 8) {
            u32x4 vv[8];
#pragma unroll
            for (int k = 0; k < 8; ++k) vv[k] = *(const u32x4*)(src + (size_t)(tid + (k0 + k) * NTHREADS) * 8);
#pragma unroll
            for (int k = 0; k < 8; ++k) *(LAS u32x4*)(lds + (tid + (k0 + k) * NTHREADS) * 16) = vv[k];
        }
        __syncthreads();
    }
    bf16x8 qf[2][4];
#pragma unroll
    for (int i2 = 0; i2 < 2; ++i2) { const bf16_t* qp = QF + ((size_t)((((R0 >> 4) + itb + i2) * 4 + h) * 4) * 64 + lane) * 8;
#pragma unroll
        for (int ks = 0; ks < 4; ++ks) qf[i2][ks] = __builtin_nontemporal_load((const bf16x8*)(qp + ks * 512)); }
    f32x4 acc[2][8];
#pragma unroll
    for (int i2 = 0; i2 < 2; ++i2)
#pragma unroll
        for (int et = 0; et < 8; ++et) acc[i2][et] = (f32x4){0.f, 0.f, 0.f, 0.f};
#pragma unroll
    for (int eq = 0; eq < 4; ++eq) {
        bf16x8 sf[2][4];
#pragma unroll
        for (int e2 = 0; e2 < 2; ++e2)
#pragma unroll
            for (int ks = 0; ks < 4; ++ks) sf[e2][ks] = *(const LAS bf16x8*)(lds + ((h * 8 + eq * 2 + e2) * 4 + ks) * 1024 + lane * 16);
#pragma unroll
        for (int e2 = 0; e2 < 2; ++e2)
#pragma unroll
            for (int ks = 0; ks < 4; ++ks) {
                acc[0][eq * 2 + e2] = __builtin_amdgcn_mfma_f32_16x16x32_bf16(sf[e2][ks], qf[0][ks], acc[0][eq * 2 + e2], 0, 0, 0);
                acc[1][eq * 2 + e2] = __builtin_amdgcn_mfma_f32_16x16x32_bf16(sf[e2][ks], qf[1][ks], acc[1][eq * 2 + e2], 0, 0, 0); }
    }
#pragma unroll
    for (int i2 = 0; i2 < 2; ++i2) { const float dec = fexp2((float)(16 * (itg0 + i2) + lr + 1) * lg);
#pragma unroll
        for (int et = 0; et < 8; ++et) acc[i2][et] *= dec; }
#pragma unroll
    for (int jp = 0; jp < NPAIR; ++jp) {
        if (2 * jp <= itg0 + 1) {
            bf16x8 kf[2][4], vf[8];
#pragma unroll
            for (int hf = 0; hf < 2; ++hf) { const bf16_t* kp = KF + ((size_t)((((t0 >> 4) + 2 * jp + hf) * 4 + h) * 4) * 64 + lane) * 8;
#pragma unroll
                for (int ks = 0; ks < 4; ++ks) kf[hf][ks] = *(const bf16x8*)(kp + ks * 512); }
#pragma unroll
            for (int et = 0; et < 8; ++et) vf[et] = *(const bf16x8*)(VT + ((size_t)((((b * 4 + h) * 16 + n) * 4 + jp) * 128 + 16 * et + lr)) * 32 + 8 * q4);
            __builtin_amdgcn_sched_barrier(0);
#pragma unroll
            for (int i2 = 0; i2 < 2; ++i2) {
                const int itg = itg0 + i2;
                if (2 * jp <= itg) {
                    unsigned pw[4];
#pragma unroll
                    for (int hf = 0; hf < 2; ++hf) {
                        f32x4 sacc = {0.f, 0.f, 0.f, 0.f};
#pragma unroll
                        for (int ks = 0; ks < 4; ++ks) sacc = __builtin_amdgcn_mfma_f32_16x16x32_bf16(kf[hf][ks], qf[i2][ks], sacc, 0, 0, 0);
                        float pv[4];
#pragma unroll
                        for (int r = 0; r < 4; ++r) { const int diff = (16 * itg + lr) - (16 * (2 * jp + hf) + 4 * q4 + r); pv[r] = (diff >= 0) ? sacc[r] * fexp2((float)diff * lg) : 0.f; }
                        pw[2 * hf] = cvt_pk_bf16(pv[0], pv[1]); pw[2 * hf + 1] = cvt_pk_bf16(pv[2], pv[3]);
                    }
                    const bf16x8 P = __builtin_bit_cast(bf16x8, (u32x4){pw[0], pw[1], pw[2], pw[3]});
#pragma unroll
                    for (int et = 0; et < 8; ++et) acc[i2][et] = __builtin_amdgcn_mfma_f32_16x16x32_bf16(vf[et], P, acc[i2][et], 0, 0, 0);
                }
            }
        }
    }
#pragma unroll
    for (int i2 = 0; i2 < 2; ++i2) {
        const size_t row = (size_t)R0 + 16 * (itb + i2) + lr;
        u32x2 gqv[8];
#pragma unroll
        for (int et = 0; et < 8; ++et) gqv[et] = __builtin_nontemporal_load((const u32x2*)(G2 + g2_index(row, 512 + h * 128 + 16 * et + 4 * q4)));
        float ss = 0.f;
#pragma unroll
        for (int et = 0; et < 8; ++et)
#pragma unroll
            for (int r = 0; r < 4; ++r) ss += acc[i2][et][r] * acc[i2][et][r];
        ss += __shfl_xor(ss, 16); ss += __shfl_xor(ss, 32);
        const float rstd = rsqrtf(ss * (1.0f / 128.0f) + EPSN);
#pragma unroll
        for (int et = 0; et < 8; ++et) { const int col = 512 + h * 128 + 16 * et + 4 * q4;
            const u32x2 gg = gqv[et];
            const float g0 = __uint_as_float(gg.x << 16), g1 = __uint_as_float(gg.x & 0xffff0000u), g2 = __uint_as_float(gg.y << 16), g3 = __uint_as_float(gg.y & 0xffff0000u);
            u32x2 o; o.x = cvt_pk_bf16(acc[i2][et][0] * rstd * silu_f(g0), acc[i2][et][1] * rstd * silu_f(g1)); o.y = cvt_pk_bf16(acc[i2][et][2] * rstd * silu_f(g2), acc[i2][et][3] * rstd * silu_f(g3));
            *(u32x2*)(MIX + mixf_index(row, col)) = o; }
    }
}

__device__ void mixer_task(const Params& p_, int l, int tile, LAS unsigned char* lds) {
    const Params p = gp(p_);
    unsigned char* const wsb = ows(p.ws);
    const int tid = otid(), w = __builtin_amdgcn_readfirstlane(tid >> 6), lane = tid & 63, q4 = lane >> 4, lr = lane & 15;
    const int R0 = tile * 64;
    const bf16_t* ZB = (const bf16_t*)(wsb + WS_ZB); bf16_t* MIX = (bf16_t*)(wsb + WS_MIX);
    LAS bf16_t* U = (LAS bf16_t*)lds;
    LAS bf16_t* Mm = (LAS bf16_t*)(lds + 80896);
    {
        const int tl0 = R0 & 2047;
        u32x4 v[10];
#pragma unroll
        for (int k = 0; k < 10; ++k) { const int idx = tid + k * NTHREADS, rr = idx >> 6, c8 = (idx & 63) * 8;
            v[k] = (u32x4){0u, 0u, 0u, 0u};
            if (idx < 79 * 64 && tl0 - 15 + rr >= 0) v[k] = __builtin_nontemporal_load((const u32x4*)(ZB + (size_t)(R0 - 15 + rr) * DIN + c8)); }
#pragma unroll
        for (int k = 0; k < 10; ++k) { const int idx = tid + k * NTHREADS, rr = idx >> 6, c8 = (idx & 63) * 8;
            if (idx < 79 * 64) *(LAS u32x4*)(U + rr * 512 + c8) = v[k]; }
        __syncthreads();
        const int c = tid, win = 2 << (c >> 7);
        float s = 0.f;
        for (int k = 1; k < win; ++k) s += bf2f(U[(15 - k) * 512 + c]);
#pragma unroll 8
        for (int ii = 0; ii < 64; ++ii) { const int tl = tl0 + ii;
            const float cur = bf2f(U[(15 + ii) * 512 + c]); s += cur;
            const int cnt = (tl + 1 < win) ? (tl + 1) : win;
            Mm[ii * 520 + c] = f2bf(s * __builtin_amdgcn_rcpf((float)cnt) - cur);
            s -= bf2f(U[(15 + ii - (win - 1)) * 512 + c]); }
        __syncthreads();
        const int g = w >> 1;
        const bf16_t* WpT = (const bf16_t*)(wsb + WS_WPOOL) + (size_t)(l * 4 + g) * 16384;
        bf16x8 af[2][4];
#pragma unroll
        for (int m2 = 0; m2 < 2; ++m2)
#pragma unroll
            for (int ks = 0; ks < 4; ++ks) af[m2][ks] = *(const LAS bf16x8*)(Mm + (16 * (2 * (w & 1) + m2) + lr) * 520 + g * 128 + ks * 32 + 8 * q4);
#pragma unroll
        for (int nh = 0; nh < 2; ++nh) {
            bf16x8 bfr[4][4]; u32x2 gq[2][4]; f32x4 psc[4];
#pragma unroll
            for (int n2 = 0; n2 < 4; ++n2) { const bf16_t* bp = WpT + (size_t)(16 * (nh * 4 + n2) + lr) * 128 + 8 * q4;
#pragma unroll
                for (int ks = 0; ks < 4; ++ks) bfr[n2][ks] = *(const bf16x8*)(bp + ks * 32);
                const int col = g * 128 + 16 * (nh * 4 + n2) + 4 * q4;
                psc[n2] = *(const f32x4*)(p.pool_scale + l * 512 + col);
#pragma unroll
                for (int m2 = 0; m2 < 2; ++m2) gq[m2][n2] = __builtin_nontemporal_load((const u32x2*)((const bf16_t*)(wsb + WS_G2) + g2_index((size_t)R0 + 16 * (2 * (w & 1) + m2) + lr, col))); }
            __builtin_amdgcn_sched_barrier(0);
#pragma unroll
            for (int m2 = 0; m2 < 2; ++m2)
#pragma unroll
                for (int n2 = 0; n2 < 4; ++n2) {
                    f32x4 acc = {0.f, 0.f, 0.f, 0.f};
#pragma unroll
                    for (int ks = 0; ks < 4; ++ks) acc = __builtin_amdgcn_mfma_f32_16x16x32_bf16(bfr[n2][ks], af[m2][ks], acc, 0, 0, 0);
                    const size_t row = (size_t)R0 + 16 * (2 * (w & 1) + m2) + lr; const int col = g * 128 + 16 * (nh * 4 + n2) + 4 * q4;
                    const u32x2 gg = gq[m2][n2];
                    const float g0 = __uint_as_float(gg.x << 16), g1 = __uint_as_float(gg.x & 0xffff0000u), g2 = __uint_as_float(gg.y << 16), g3 = __uint_as_float(gg.y & 0xffff0000u);
                    u32x2 o; o.x = cvt_pk_bf16(acc[0] * psc[n2][0] * silu_f(g0), acc[1] * psc[n2][1] * silu_f(g1)); o.y = cvt_pk_bf16(acc[2] * psc[n2][2] * silu_f(g2), acc[3] * psc[n2][3] * silu_f(g3));
                    *(u32x2*)(MIX + mixf_index(row, col)) = o;
                }
        }
        __syncthreads();
    }
    if ((R0 >> 6) & 1) retention_part<4>(p, R0, w, q4, lr, lds, tid); else retention_part<2>(p, R0, w, q4, lr, lds, tid);
}

__device__ void mini_gemm_task(const Params& p_, int l, int t, LAS unsigned char* lds) {
    const Params p = gp(p_);
    unsigned char* const wsb = ows(p.ws);
    const int tid = otid(), w = __builtin_amdgcn_readfirstlane(tid >> 6), lane = tid & 63, q4 = lane >> 4, lr = lane & 15;
    const int tm = t >> 4, tn = t & 15, mp = w & 1, nh = (w >> 1) & 1, kh = w >> 2;
    constexpr int MGP = 2048 + 64;
    LAS unsigned char* const As = lds + 16384;
    {
        const bf16_t* src = (const bf16_t*)(wsb + WS_MIX) + ((size_t)NP + 64 * tm) * DM;
        u32x4 vv[16];
#pragma unroll
        for (int k = 0; k < 16; ++k) { const int pi = tid + k * NTHREADS; vv[k] = *(const u32x4*)(src + (size_t)(pi >> 7) * DM + (pi & 127) * 8); }
#pragma unroll
        for (int k = 0; k < 16; ++k) { const int pi = tid + k * NTHREADS; *(LAS u32x4*)(As + (pi >> 7) * MGP + (pi & 127) * 16) = vv[k]; }
        __syncthreads();
    }
    const LAS unsigned char* ap0 = As + (32 * mp + lr) * MGP + (512 * kh + 8 * q4) * 2;
    const LAS unsigned char* ap1 = ap0 + 16 * MGP;
    const bf16_t* bp0 = (const bf16_t*)(wsb + WS_WO) + (size_t)l * DM * DM + ((size_t)((tn * 4 + 2 * nh) * 32 + 16 * kh) * 64 + lane) * 8;
    const bf16_t* bp1 = bp0 + 32 * 512;
    f32x4 acc[2][2];
#pragma unroll
    for (int i = 0; i < 2; ++i)
#pragma unroll
        for (int j = 0; j < 2; ++j) acc[i][j] = (f32x4){0.f, 0.f, 0.f, 0.f};
    bf16x8 fa0[2][4], fa1[2][4], fb0[2][4], fb1[2][4];
#define MG_LOAD(s_, kb) do { _Pragma("unroll") for (int k = 0; k < 4; ++k) { fa0[s_][k] = *(const LAS bf16x8*)(ap0 + ((kb) * 4 + k) * 64); fa1[s_][k] = *(const LAS bf16x8*)(ap1 + ((kb) * 4 + k) * 64); \
        fb0[s_][k] = *(const bf16x8*)(bp0 + ((kb) * 4 + k) * 512); fb1[s_][k] = *(const bf16x8*)(bp1 + ((kb) * 4 + k) * 512); } } while (0)
#define MG_MMA(s_) do { _Pragma("unroll") for (int k = 0; k < 4; ++k) { \
        acc[0][0] = __builtin_amdgcn_mfma_f32_16x16x32_bf16(fb0[s_][k], fa0[s_][k], acc[0][0], 0, 0, 0); acc[0][1] = __builtin_amdgcn_mfma_f32_16x16x32_bf16(fb1[s_][k], fa0[s_][k], acc[0][1], 0, 0, 0); \
        acc[1][0] = __builtin_amdgcn_mfma_f32_16x16x32_bf16(fb0[s_][k], fa1[s_][k], acc[1][0], 0, 0, 0); acc[1][1] = __builtin_amdgcn_mfma_f32_16x16x32_bf16(fb1[s_][k], fa1[s_][k], acc[1][1], 0, 0, 0); } } while (0)
    MG_LOAD(0, 0);
#pragma unroll
    for (int kb = 0; kb < 4; kb += 2) {
        MG_LOAD(1, kb + 1);
        __builtin_amdgcn_sched_barrier(0);
        MG_MMA(0);
        __builtin_amdgcn_sched_barrier(0);
        if (kb + 2 < 4) MG_LOAD(0, kb + 2);
        __builtin_amdgcn_sched_barrier(0);
        MG_MMA(1);
        __builtin_amdgcn_sched_barrier(0);
    }
#undef MG_LOAD
#undef MG_MMA
    LAS f32x4* red = (LAS f32x4*)lds;
    if (kh == 1) {
#pragma unroll
        for (int i = 0; i < 2; ++i)
#pragma unroll
            for (int j = 0; j < 2; ++j) red[((w & 3) * 4 + i * 2 + j) * 64 + lane] = acc[i][j];
    }
    __syncthreads();
    if (kh == 0) {
#pragma unroll
        for (int i = 0; i < 2; ++i) {
            float* yp = (float*)(wsb + WS_Y) + ((size_t)NP + 64 * tm + 32 * mp + 16 * i + lr) * DM + 64 * tn + 32 * nh + 4 * q4;
            *(f32x4*)yp = acc[i][0] + red[((w & 3) * 4 + i * 2 + 0) * 64 + lane]; *(f32x4*)(yp + 16) = acc[i][1] + red[((w & 3) * 4 + i * 2 + 1) * 64 + lane];
        }
    }
    __syncthreads();
}

__device__ void inproj_s_task(const Params& p_, int l, int t, LAS unsigned char* lds, bool stage_a) {
    const Params p = gp(p_);
    unsigned char* const wsb = ows(p.ws);
    const int tid = otid(), w = __builtin_amdgcn_readfirstlane(tid >> 6), lane = tid & 63, q4 = lane >> 4, lr = lane & 15;
    const int tm = t / 24, sn = t % 24, jn = w & 3, kh = w >> 2;
    LAS unsigned char* const As = lds + 32768;
    if (stage_a) {
        const bf16_t* src = (const bf16_t*)(wsb + WS_HSF) + (size_t)(2 * tm) * 32 * 512;
        u32x4 vv[8];
#pragma unroll
        for (int k = 0; k < 8; ++k) vv[k] = *(const u32x4*)(src + (size_t)(tid + k * NTHREADS) * 8);
#pragma unroll
        for (int k = 0; k < 8; ++k) *(LAS u32x4*)(As + (tid + k * NTHREADS) * 16) = vv[k];
        __syncthreads();
    }
    const LAS unsigned char* ap0 = As + (16 * kh) * 1024 + lane * 16;
    const LAS unsigned char* ap1 = ap0 + 32 * 1024;
    const bf16_t* bp0 = (const bf16_t*)(wsb + WS_WINF) + (size_t)l * DIN * DM + ((size_t)((sn * 8 + jn) * 32 + 16 * kh) * 64 + lane) * 8;
    const bf16_t* bp1 = bp0 + (size_t)4 * 32 * 512;
    f32x4 acc[2][2];
#pragma unroll
    for (int i = 0; i < 2; ++i)
#pragma unroll
        for (int j = 0; j < 2; ++j) acc[i][j] = (f32x4){0.f, 0.f, 0.f, 0.f};
    bf16x8 fa0[2][4], fa1[2][4], fb0[2][4], fb1[2][4];
#define IS_LOAD(s_, kb) do { _Pragma("unroll") for (int k = 0; k < 4; ++k) { fa0[s_][k] = *(const LAS bf16x8*)(ap0 + ((kb) * 4 + k) * 1024); fa1[s_][k] = *(const LAS bf16x8*)(ap1 + ((kb) * 4 + k) * 1024); \
        fb0[s_][k] = *(const bf16x8*)(bp0 + ((kb) * 4 + k) * 512); fb1[s_][k] = *(const bf16x8*)(bp1 + ((kb) * 4 + k) * 512); } } while (0)
#define IS_MMA(s_) do { _Pragma("unroll") for (int k = 0; k < 4; ++k) { \
        acc[0][0] = __builtin_amdgcn_mfma_f32_16x16x32_bf16(fb0[s_][k], fa0[s_][k], acc[0][0], 0, 0, 0); acc[0][1] = __builtin_amdgcn_mfma_f32_16x16x32_bf16(fb1[s_][k], fa0[s_][k], acc[0][1], 0, 0, 0); \
        acc[1][0] = __builtin_amdgcn_mfma_f32_16x16x32_bf16(fb0[s_][k], fa1[s_][k], acc[1][0], 0, 0, 0); acc[1][1] = __builtin_amdgcn_mfma_f32_16x16x32_bf16(fb1[s_][k], fa1[s_][k], acc[1][1], 0, 0, 0); } } while (0)
    IS_LOAD(0, 0);
#pragma unroll
    for (int kb = 0; kb < 4; kb += 2) {
        IS_LOAD(1, kb + 1);
        __builtin_amdgcn_sched_barrier(0);
        IS_MMA(0);
        __builtin_amdgcn_sched_barrier(0);
        if (kb + 2 < 4) IS_LOAD(0, kb + 2);
        __builtin_amdgcn_sched_barrier(0);
        IS_MMA(1);
        __builtin_amdgcn_sched_barrier(0);
    }
#undef IS_LOAD
#undef IS_MMA
    LAS f32x4* red = (LAS f32x4*)lds;
    if (kh == 1) {
#pragma unroll
        for (int i = 0; i < 2; ++i)
#pragma unroll
            for (int j = 0; j < 2; ++j) red[(jn * 4 + i * 2 + j) * 64 + lane] = acc[i][j];
    }
    __syncthreads();
    if (kh == 0) {
#pragma unroll
        for (int mt = 0; mt < 2; ++mt) {
            const int rs = 32 * tm + 16 * mt + lr, row = NP + rs, colb = 128 * sn, d0 = 16 * jn + 4 * q4;
            f32x4 v0 = acc[mt][0] + red[(jn * 4 + mt * 2 + 0) * 64 + lane], v1 = acc[mt][1] + red[(jn * 4 + mt * 2 + 1) * 64 + lane];
            if (sn >= 4 && sn < 12) {
                const int tpos = 2048 + (rs & 7);
                const f32x4 c4 = *(const f32x4*)((const float*)(wsb + WS_COS) + tpos * 64 + d0), s4 = *(const f32x4*)((const float*)(wsb + WS_SIN) + tpos * 64 + d0);
                f32x4 r0 = v0 * c4 - v1 * s4, r1 = v0 * s4 + v1 * c4;
                if (sn >= 8) { r0 *= 0.08838834764831845f; r1 *= 0.08838834764831845f; }
                v0 = r0; v1 = r1;
            }
            u32x2 w0, w1; w0.x = cvt_pk_bf16(v0[0], v0[1]); w0.y = cvt_pk_bf16(v0[2], v0[3]); w1.x = cvt_pk_bf16(v1[0], v1[1]); w1.y = cvt_pk_bf16(v1[2], v1[3]);
            bf16_t* zp = (bf16_t*)(wsb + WS_ZB) + (size_t)row * DIN + colb + d0;
            *(u32x2*)zp = w0; *(u32x2*)(zp + 64) = w1;
            if (sn < 4) { float* pp = p.out + OUT_POOLS + (size_t)l * SB * 15 * 512 + ((size_t)((rs >> 3) * 15 + 7 + (rs & 7))) * 512 + colb + d0; *(f32x4*)pp = v0; *(f32x4*)(pp + 64) = v1; }
        }
    }
    __syncthreads();
}

__device__ void fusedp_task(const Params& p_, int l, int tile, LAS unsigned char* lds) {
    const Params p = gp(p_);
    unsigned char* const wsb = ows(p.ws);
    const int tid = otid(), w = __builtin_amdgcn_readfirstlane(tid >> 6), lane = tid & 63, q4 = lane >> 4, lr = lane & 15;
    const int R0 = tile * 64, brow = R0 >> 11;
    const bf16_t* MIX = (const bf16_t*)(wsb + WS_MIX); const bf16_t* WoT = (const bf16_t*)(wsb + WS_WO) + (size_t)l * DM * DM;
    const float* mod = (const float*)(wsb + WS_MOD); float* XR = (float*)(wsb + WS_XR); bf16_t* H = (bf16_t*)(wsb + WS_H);
    LAS unsigned char* At = lds;
    {
        const bf16_t* src = MIX + (size_t)(R0 >> 4) * 32 * 512;
        u32x4 v[16];
#pragma unroll
        for (int k = 0; k < 16; ++k) v[k] = __builtin_nontemporal_load((const u32x4*)(src + (size_t)(tid + k * NTHREADS) * 8));
#pragma unroll
        for (int k = 0; k < 16; ++k) *(LAS u32x4*)(At + (tid + k * NTHREADS) * 16) = v[k];
    }
    __syncthreads();
    f32x4 acc[4][8];
#pragma unroll
    for (int mt = 0; mt < 4; ++mt)
#pragma unroll
        for (int nt = 0; nt < 8; ++nt) acc[mt][nt] = (f32x4){0.f, 0.f, 0.f, 0.f};
    const bf16_t* bp = WoT + ((size_t)(w * 8) * 32 * 64 + lane) * 8;
    bf16x8 B0[8], B1[8];
#define FP_LOADB(dst, kk) do { _Pragma("unroll") for (int nt = 0; nt < 8; ++nt) dst[nt] = *(const bf16x8*)(bp + (size_t)(nt * 32 + (kk)) * 512); } while (0)
#define FP_STEP(Bx, kk) do { bf16x8 Af[4]; \
        _Pragma("unroll") for (int mt = 0; mt < 4; ++mt) Af[mt] = *(const LAS bf16x8*)(At + (mt * 32 + (kk)) * 1024 + lane * 16); \
        _Pragma("unroll") for (int mt = 0; mt < 4; ++mt) _Pragma("unroll") for (int nt = 0; nt < 8; ++nt) acc[mt][nt] = __builtin_amdgcn_mfma_f32_16x16x32_bf16(Bx[nt], Af[mt], acc[mt][nt], 0, 0, 0); } while (0)
    FP_LOADB(B0, 0);
#pragma unroll 1
    for (int ks = 0; ks < 32; ks += 2) {
        FP_LOADB(B1, ks + 1);
        __builtin_amdgcn_sched_barrier(0);
        FP_STEP(B0, ks);
        __builtin_amdgcn_sched_barrier(0);
        { const int kn = ks + 2 < 32 ? ks + 2 : 31; FP_LOADB(B0, kn); }
        __builtin_amdgcn_sched_barrier(0);
        FP_STEP(B1, ks + 1);
        __builtin_amdgcn_sched_barrier(0);
    }
#undef FP_LOADB
#undef FP_STEP
    constexpr int YP = 4096 + 64;
    const float* xin = (l == 0) ? p.x_prompt : (const float*)XR; float* xo = (l == DEPTH - 1) ? p.out : XR;
    f32x4 gg[4], aa[4], sh[4];
#pragma unroll
    for (int j = 0; j < 4; ++j) { const int col = lane * 4 + j * 256;
        gg[j] = *(const f32x4*)(mod + (size_t)brow * MODLD + l * 3072 + 2048 + col) * *(const f32x4*)(p.g_post + l * DM + col);
        if (l < DEPTH - 1) { aa[j] = *(const f32x4*)(p.g_pre + (l + 1) * DM + col) * (1.0f + *(const f32x4*)(mod + (size_t)brow * MODLD + (l + 1) * 3072 + 1024 + col));
            sh[j] = *(const f32x4*)(mod + (size_t)brow * MODLD + (l + 1) * 3072 + col); }
        else { aa[j] = (f32x4){0.f, 0.f, 0.f, 0.f}; sh[j] = (f32x4){0.f, 0.f, 0.f, 0.f}; } }
#define FP_LOADX(dst, half_, k2_) do { _Pragma("unroll") for (int k = 0; k < 2; ++k) { const size_t off_ = (size_t)(R0 + 32 * (half_) + 4 * w + 2 * (k2_) + k) * DM; \
        _Pragma("unroll") for (int j = 0; j < 4; ++j) dst[k][j] = __builtin_nontemporal_load((const f32x4*)(xin + off_ + lane * 4 + j * 256)); } } while (0)
#define FP_ROWS(xv, half_, k2_) do { _Pragma("unroll") for (int k = 0; k < 2; ++k) { const int rl = 4 * w + 2 * (k2_) + k; const size_t off = (size_t)(R0 + 32 * (half_) + rl) * DM; \
        f32x4 y[4]; float ss = 0.f; \
        _Pragma("unroll") for (int j = 0; j < 4; ++j) { y[j] = *(const LAS f32x4*)(lds + rl * YP + (lane * 4 + j * 256) * 4); ss += y[j][0] * y[j][0] + y[j][1] * y[j][1] + y[j][2] * y[j][2] + y[j][3] * y[j][3]; } \
        ss = wave_sum(ss); const float rsy = rsqrtf(ss * (1.0f / DM) + EPSN); \
        float sx = 0.f; \
        _Pragma("unroll") for (int j = 0; j < 4; ++j) { const f32x4 v = xv[k][j] + gg[j] * (y[j] * rsy); y[j] = v; __builtin_nontemporal_store(v, (f32x4*)(xo + off + lane * 4 + j * 256)); \
            sx += v[0] * v[0] + v[1] * v[1] + v[2] * v[2] + v[3] * v[3]; } \
        if (l < DEPTH - 1) { \
            sx = wave_sum(sx); const float rsx = rsqrtf(sx * (1.0f / DM) + EPSN); \
            _Pragma("unroll") for (int j = 0; j < 4; ++j) { const f32x4 hv = y[j] * rsx * aa[j] + sh[j]; \
                u32x2 o; o.x = cvt_pk_bf16(hv[0], hv[1]); o.y = cvt_pk_bf16(hv[2], hv[3]); \
                __builtin_nontemporal_store(o, (u32x2*)(H + off + lane * 4 + j * 256)); } } } } while (0)
    f32x4 xa[2][4], xb[2][4];
    FP_LOADX(xa, 0, 0);
#pragma unroll
    for (int half = 0; half < 2; ++half) {
        __syncthreads();
#pragma unroll
        for (int m2 = 0; m2 < 2; ++m2)
#pragma unroll
            for (int nt = 0; nt < 8; ++nt) *(LAS f32x4*)(lds + (16 * m2 + lr) * YP + (128 * w + 16 * nt + 4 * q4) * 4) = acc[2 * half + m2][nt];
        __syncthreads();
        FP_LOADX(xb, half, 1);
        __builtin_amdgcn_sched_barrier(0);
        FP_ROWS(xa, half, 0);
        __builtin_amdgcn_sched_barrier(0);
        if (half == 0) FP_LOADX(xa, 1, 0);
        __builtin_amdgcn_sched_barrier(0);
        FP_ROWS(xb, half, 1);
        __builtin_amdgcn_sched_barrier(0);
    }
#undef FP_LOADX
#undef FP_ROWS
    __syncthreads();
}

#define LOADP(q) Params q; { typedef void* const __attribute__((address_space(4)))* kp_t; kp_t kp_ = (kp_t)__builtin_amdgcn_kernarg_segment_ptr(); asm volatile("" : "+s"(kp_)); \
    q.x_prompt = (const float*)kp_[0]; q.x_sample = (const float*)kp_[1]; q.c_prompt = (const float*)kp_[2]; q.c_sample = (const float*)kp_[3]; q.state_ret = (const float*)kp_[4]; q.state_pool = (const float*)kp_[5]; \
    q.w_ada = (const float*)kp_[6]; q.b_ada = (const float*)kp_[7]; q.g_pre = (const float*)kp_[8]; q.g_post = (const float*)kp_[9]; q.w_in = (const float*)kp_[10]; q.w_pool = (const float*)kp_[11]; \
    q.pool_scale = (const float*)kp_[12]; q.w_o = (const float*)kp_[13]; q.out = (float*)kp_[14]; q.ws = (unsigned char*)kp_[15]; }

__global__ void __launch_bounds__(NTHREADS) fwd_megakernel(Params p_arg) {
    extern __shared__ __attribute__((aligned(16))) unsigned char lds_raw[];
    LAS unsigned char* lds = (LAS unsigned char*)lds_raw;
    cg::grid_group grid = cg::this_grid();
    const int G = gridDim.x, bx = blockIdx.x;
    volatile LAS unsigned* bst = (volatile LAS unsigned*)(lds + LDS_USER);
    if (threadIdx.x < 4) bst[threadIdx.x] = 0u;
    __syncthreads();
    const XcdBarrier xbar = xcd_barrier_post((unsigned*)(p_arg.ws + WS_BAR), bst);
#define GSYNC() xcd_barrier(xbar)

    { LOADP(p); phase_prep(p, lds); }
    grid.sync();
    {   LOADP(p);
        pg8::Gemm g{(const bf16_t*)(p.ws + WS_SC), (const bf16_t*)(p.ws + WS_WADA), 256, MODLD, DM};
        pg8::StaticOrder S; S.init(256, MODLD, G, bx);
        pg8::EpiF32 E{(float*)(p.ws + WS_MOD), MODLD, p.b_ada};
        pg8::gemm_phase<pg8::EpiF32, pg8::StaticOrder>(lds, g, S, E);
    }
    GSYNC();
    { LOADP(p); phase_rows(p, -1, 0, 0, NTOK); }
    GSYNC();
#pragma unroll 1
    for (int l = 0; l < DEPTH; ++l) {
        {   LOADP(p);
            pg8::Gemm g{(const bf16_t*)(p.ws + WS_H), (const bf16_t*)(p.ws + WS_WIN) + (size_t)l * DIN * DM, NP, DIN, DM};
            pg8::StaticOrder S; S.init(NP, DIN, G, bx);
            pg8::EpiZ E{p.ws, p.out + OUT_POOLP + (size_t)l * NB * 15 * 512, p.out + OUT_POOLS + (size_t)l * SB * 15 * 512};
            pg8::gemm_phase<pg8::EpiZ, pg8::StaticOrder>(lds, g, S, E);
        }
        { LOADP(p); int prev_tm = -1; for (int t = bx; t < 32 * 24; t += G) { const int r = t >> 8, c = t & 255, x = c & 7, i = c >> 3; inproj_s_task(p, l, i * 24 + x * 3 + r, lds, i != prev_tm); prev_tm = i; } }
        GSYNC();
        { LOADP(p); for (int t = bx; t < 256; t += G) { const int x = t & 7, i = t >> 3; kvscan_task(p, l, (x * 4 + (i >> 3)) * 8 + (i & 7), lds); } }
        { LOADP(p); for (int t = bx; t < 512; t += G) rs_task(p, l, t, lds); }
        GSYNC();
        { LOADP(p); for (int t = bx; t < NP / 64; t += G) { const int x = t & 7, i = t >> 3; mixer_task(p, l, 2 * (x * 16 + (i >> 1)) + (i & 1), lds); } }
        { LOADP(p); for (int t = bx; t < 256; t += G) { const int x = t & 7, i = t >> 3; mini_gemm_task(p, l, (i >> 1) * 16 + 2 * x + (i & 1), lds); } }
        GSYNC();
        { LOADP(p); for (int t = bx; t < NP / 64; t += G) fusedp_task(p, l, t, lds); }
        { LOADP(p); phase_rows(p, l, l + 1, NP, NTOK); }
        GSYNC();
    }
}

extern "C" void kernel_launch(void* const* d_in, const int* in_sizes, int n_in, void* d_out, int out_size, void* d_ws, size_t ws_size, hipStream_t stream) {
    static int grid_blocks = 0;
    if (grid_blocks == 0) {
        if (n_in != 14 || (size_t)out_size != OUT_END || ws_size < WS_END) { fprintf(stderr, "kernel_launch: unexpected shapes (n_in %d out %d ws %zu need %zu)\n", n_in, out_size, ws_size, (size_t)WS_END); grid_blocks = -1; return; }
        int dev = 0, cus = 0, per_cu = 0;
        (void)hipGetDevice(&dev);
        (void)hipDeviceGetAttribute(&cus, hipDeviceAttributeMultiprocessorCount, dev);
        if (hipFuncSetAttribute((const void*)fwd_megakernel, hipFuncAttributeMaxDynamicSharedMemorySize, LDS_BYTES) != hipSuccess) { fprintf(stderr, "kernel_launch: hipFuncSetAttribute failed\n"); grid_blocks = -1; return; }
        if (hipOccupancyMaxActiveBlocksPerMultiprocessor(&per_cu, (const void*)fwd_megakernel, NTHREADS, LDS_BYTES) != hipSuccess || per_cu < 1) { fprintf(stderr, "kernel_launch: occupancy query failed (%d)\n", per_cu); per_cu = 1; (void)hipGetLastError(); }
        grid_blocks = cus;
    }
    if (grid_blocks < 0) return;
    Params p{};
    p.x_prompt = (const float*)d_in[0]; p.x_sample = (const float*)d_in[1]; p.c_prompt = (const float*)d_in[2]; p.c_sample = (const float*)d_in[3];
    p.state_ret = (const float*)d_in[4]; p.state_pool = (const float*)d_in[5]; p.w_ada = (const float*)d_in[6]; p.b_ada = (const float*)d_in[7];
    p.g_pre = (const float*)d_in[8]; p.g_post = (const float*)d_in[9]; p.w_in = (const float*)d_in[10]; p.w_pool = (const float*)d_in[11];
    p.pool_scale = (const float*)d_in[12]; p.w_o = (const float*)d_in[13];
    p.out = (float*)d_out; p.ws = (unsigned char*)d_ws;
    if (hipMemsetAsync((char*)d_ws + WS_BAR, 0, XCD_BAR_WORDS * 4, stream) != hipSuccess) { fprintf(stderr, "kernel_launch: memset failed\n"); return; }
    void* args[] = {&p};
    hipError_t e = hipLaunchCooperativeKernel((const void*)fwd_megakernel, dim3(grid_blocks), dim3(NTHREADS), args, LDS_BYTES, stream);
    if (e != hipSuccess) fprintf(stderr, "cooperative launch failed: %s (grid %d)\n", hipGetErrorString(e), grid_blocks);
}
```

```cpp
#include <hip/hip_runtime.h>
#include <hip/hip_cooperative_groups.h>
#include <cstdio>
#include <cstdint>
namespace cg = cooperative_groups;

#define LAS __attribute__((address_space(3)))
typedef unsigned short bf16_t;
typedef short bf16x8 __attribute__((ext_vector_type(8)));
typedef float f32x4 __attribute__((ext_vector_type(4)));
typedef unsigned u32x4 __attribute__((ext_vector_type(4)));
typedef unsigned u32x2 __attribute__((ext_vector_type(2)));

constexpr int DM = 1024, NP = 16384, NS = 1024, NTOK = NP + NS, DIN = 3072, DEPTH = 4;
constexpr int LP = 2048, NB = 8, SB = 128, SL = 8;
constexpr int MODLD = DEPTH * 3 * DM;
constexpr float EPSN = 1e-6f;

__device__ __forceinline__ bf16_t f2bf(float f) { unsigned u = __float_as_uint(f); u += 0x7FFFu + ((u >> 16) & 1u); return (bf16_t)(u >> 16); }
__device__ __forceinline__ float bf2f(bf16_t b) { return __uint_as_float(((unsigned)b) << 16); }
__device__ __forceinline__ unsigned cvt_pk_bf16(float lo, float hi) { unsigned r; asm volatile("v_cvt_pk_bf16_f32 %0, %1, %2" : "=v"(r) : "v"(lo), "v"(hi)); return r; }
__device__ __forceinline__ float silu_f(float x) { return x * __builtin_amdgcn_rcpf(1.0f + __builtin_amdgcn_exp2f(-1.4426950408889634f * x)); }
__device__ __forceinline__ float fexp2(float x) { return __builtin_amdgcn_exp2f(x); }
__device__ __forceinline__ float lg2gamma(int h) { return log2f(1.0f - exp2f(-5.0f - (float)h)); }
__device__ __forceinline__ float wave_sum(float v) {
#pragma unroll
    for (int o = 32; o >= 1; o >>= 1) v += __shfl_xor(v, o);
    return v;
}

#define GAS __attribute__((address_space(1)))
__device__ __forceinline__ unsigned char* ows(unsigned char* w) { GAS unsigned char* g = (GAS unsigned char*)w; asm volatile("" : "+s"(g)); return (unsigned char*)g; }
template <class T> __device__ __forceinline__ T* as_global(T* q) { GAS T* g = (GAS T*)q; asm volatile("" : "+s"(g)); return (T*)g; }
__device__ __forceinline__ int otid() { int t = (int)threadIdx.x; asm volatile("" : "+v"(t)); return t; }

constexpr size_t al256(size_t x) { return (x + 255) & ~(size_t)255; }
constexpr size_t WS_WIN = 0;
constexpr size_t WS_WO = WS_WIN + al256((size_t)DEPTH * DIN * DM * 2);
constexpr size_t WS_WADA = WS_WO + al256((size_t)DEPTH * DM * DM * 2);
constexpr size_t WS_WPOOL = WS_WADA + al256((size_t)DEPTH * DIN * DM * 2);
constexpr size_t WS_SC = WS_WPOOL + al256((size_t)DEPTH * 4 * 128 * 128 * 2);
constexpr size_t WS_MOD = WS_SC + al256((size_t)256 * DM * 2);
constexpr size_t WS_COS = WS_MOD + al256((size_t)256 * MODLD * 4);
constexpr size_t WS_SIN = WS_COS + al256((size_t)2056 * 64 * 4);
constexpr size_t WS_H = WS_SIN + al256((size_t)2056 * 64 * 4);
constexpr size_t WS_ZB = WS_H + al256((size_t)NTOK * DM * 2);
constexpr size_t WS_KTD = WS_ZB + al256((size_t)NTOK * DIN * 2);
constexpr size_t WS_VT = WS_KTD + al256((size_t)NB * 4 * 128 * LP * 2);
constexpr size_t WS_SPT = WS_VT + al256((size_t)NB * 4 * 128 * LP * 2);
constexpr size_t WS_MIX = WS_SPT + al256((size_t)NB * 16 * 4 * 128 * 128 * 2);
constexpr size_t WS_Y = WS_MIX + al256((size_t)NTOK * DM * 2);
constexpr size_t WS_WINF = WS_Y;
constexpr size_t WS_HSF = WS_Y + ((size_t)32 << 20);
constexpr size_t WS_XR = WS_Y + al256((size_t)NTOK * DM * 4);
constexpr size_t WS_QF = WS_XR + al256((size_t)NTOK * DM * 4);
constexpr size_t WS_KF = WS_QF + al256((size_t)NP * 512 * 2);
constexpr size_t WS_G2 = WS_KF + al256((size_t)NP * 512 * 2);
constexpr size_t WS_BAR = WS_G2 + al256((size_t)NP * DM * 2);
constexpr size_t WS_END = WS_BAR + al256((size_t)3456 * 4);


__device__ __forceinline__ size_t mixf_index(size_t row, int col) { return ((size_t)((row >> 4) * 32 + (col >> 5)) * 64 + (((col >> 3) & 3) * 16 + (row & 15))) * 8 + (col & 7); }
__device__ __forceinline__ size_t g2_index(size_t row, int gc) { return ((size_t)((row >> 4) * 64 + (gc >> 4)) * 64 + (((gc >> 2) & 3) * 16 + (row & 15))) * 4 + (gc & 3); }

__device__ __forceinline__ size_t pf_index(int b, int h, int t, int e) {
    return ((size_t)((((b * 4 + h) * 16 + (t >> 7)) * 4 + ((t >> 5) & 3)) * 128 + e)) * 32 + (((t & 15) >> 2) * 8) + (((t >> 4) & 1) * 4) + (t & 3);
}

namespace pg8 {
constexpr int BM = 256, BK = 64, HALF = 128, HTB = HALF * BK * 2, STAGE_BYTES = 8 * HTB, NXCD = 8, WGM = 8;
__host__ __device__ __forceinline__ int lds_byte(int r, int c) { const int st = (r >> 4) * 2 + (c >> 5), rr = r & 15, cc = c & 31, ob = rr * 64 + cc * 2; return st * 1024 + (ob ^ (((ob >> 9) & 1) << 5)); }
__host__ __device__ __forceinline__ void stage_rc(int b, int& R, int& C) { const int st = b / 1024, sb = b % 1024, swz = sb ^ (((sb >> 9) & 1) << 5); R = (st >> 1) * 16 + swz / 64; C = (st & 1) * 32 + (swz % 64) / 2; }
struct Unit { int pm, pn; };
struct Gemm { const bf16_t* A; const bf16_t* Bt; int M, N, K; };
struct StaticOrder {
    int nM, nN, nwg, G, c;
    __host__ __device__ void init(int M, int N, int G_, int c_) { nM = M / BM; nN = N / BM; nwg = nM * nN; G = G_; c = c_; }
    __host__ __device__ bool next(int i, Unit& u) const {
        const long L = (long)i * G + c; if (L >= nwg) return false;
        int wgid = (int)L; { const int q = nwg / NXCD, r = nwg % NXCD, xcd = wgid % NXCD, off = wgid / NXCD; wgid = (xcd < r ? xcd * (q + 1) : r * (q + 1) + (xcd - r) * q) + off; }
        const int nig = WGM * nN, gid = wgid / nig, fm = gid * WGM, gsz = (nM - fm) < WGM ? (nM - fm) : WGM;
        u.pm = fm + ((wgid % nig) % gsz); u.pn = (wgid % nig) / gsz; return true;
    }
    __device__ __forceinline__ void a_ready(const Unit&) const {}
    __device__ __forceinline__ void done(const Unit&) const {}
};

struct EpiF32 {
    __host__ __device__ static __forceinline__ int bperm(int R) { return R; }
    float* C; int ldc; const float* bias;
    __device__ __forceinline__ void operator()(const f32x4 (&acc)[2][2][4][2], const Unit& u, int wr, int wc, int fr, int fq) const {
        const int row0 = u.pm * BM + wr * 64 + fr, col0 = u.pn * BM + wc * 32 + 4 * fq;
        f32x4 bv[2][2];
#pragma unroll
        for (int bj = 0; bj < 2; ++bj)
#pragma unroll
            for (int n = 0; n < 2; ++n) bv[bj][n] = bias ? *(const f32x4*)(bias + col0 + bj * HALF + n * 16) : (f32x4){0.f, 0.f, 0.f, 0.f};
#pragma unroll
        for (int ai = 0; ai < 2; ++ai)
#pragma unroll
            for (int m = 0; m < 4; ++m) { float* rowp = C + (size_t)(row0 + ai * HALF + m * 16) * ldc + col0;
#pragma unroll
                for (int bj = 0; bj < 2; ++bj)
#pragma unroll
                    for (int n = 0; n < 2; ++n) *(f32x4*)(rowp + bj * HALF + n * 16) = acc[ai][bj][m][n] + bv[bj][n]; }
    }
};

struct EpiZ {
    __host__ __device__ static __forceinline__ int bperm(int R) { return 64 * ((R >> 4) & 1) + 16 * (R >> 5) + (R & 15); }
    unsigned char* ws; float* poolP; float* poolS;
    __device__ __forceinline__ void operator()(const f32x4 (&acc)[2][2][4][2], const Unit& u, int wr, int wc, int fr, int fq) const {
        const int pn = u.pn; const bool prompt = u.pm < 64;
        unsigned char* const wsg = as_global(ws); float* const poolPg = as_global(poolP); float* const poolSg = as_global(poolS);
        bf16_t* const ZB = (bf16_t*)(wsg + WS_ZB); bf16_t* const KTD = (bf16_t*)(wsg + WS_KTD); bf16_t* const VT = (bf16_t*)(wsg + WS_VT); bf16_t* const QF = (bf16_t*)(wsg + WS_QF); bf16_t* const KF = (bf16_t*)(wsg + WS_KF);
        const float* const cosT = (const float*)(wsg + WS_COS); const float* const sinT = (const float*)(wsg + WS_SIN);
        const int d0 = wc * 16 + 4 * fq;
#pragma unroll
        for (int ai = 0; ai < 2; ++ai)
#pragma unroll
            for (int m = 0; m < 4; ++m) {
                const int row = u.pm * BM + ai * HALF + wr * 64 + m * 16 + fr;
                const int tpos = prompt ? (row & 2047) : (2048 + (row & 7));
#pragma unroll
                for (int bj = 0; bj < 2; ++bj) {
                    f32x4 v0 = acc[ai][bj][m][0], v1 = acc[ai][bj][m][1];
                    const int colb = pn * BM + bj * HALF;
                    const int h = (pn & 1) * 2 + bj;
                    if (pn >= 2 && pn < 6) {
                        const f32x4 c4 = *(const f32x4*)(cosT + tpos * 64 + d0), s4 = *(const f32x4*)(sinT + tpos * 64 + d0);
                        f32x4 r0 = v0 * c4 - v1 * s4, r1 = v0 * s4 + v1 * c4;
                        if (pn >= 4) { r0 *= 0.08838834764831845f; r1 *= 0.08838834764831845f; }
                        v0 = r0; v1 = r1;
                    }
                    u32x2 w0, w1; w0.x = cvt_pk_bf16(v0[0], v0[1]); w0.y = cvt_pk_bf16(v0[2], v0[3]); w1.x = cvt_pk_bf16(v1[0], v1[1]); w1.y = cvt_pk_bf16(v1[2], v1[3]);
                    if (prompt && pn >= 2 && pn < 6) {
                        bf16_t* fp = (pn < 4 ? QF : KF) + ((size_t)((((row >> 4) * 4 + h) * 4 + (wc >> 1)) * 64 + (((2 * wc + (fq >> 1)) & 3) * 16 + fr))) * 8 + 4 * (fq & 1);
                        *(u32x2*)fp = w0; *(u32x2*)(fp + 2 * 512) = w1;
                    } else if (prompt && pn >= 8) {
                        bf16_t* gp = (bf16_t*)(wsg + WS_G2) + g2_index((size_t)row, colb - 2048 + d0);
                        *(u32x2*)gp = w0; *(u32x2*)(gp + 4 * 64 * 4) = w1;
                    } else if (!(prompt && pn >= 6 && pn < 8)) {
                        bf16_t* zp = ZB + (size_t)row * DIN + colb + d0;
                        *(u32x2*)zp = w0; *(u32x2*)(zp + 64) = w1;
                    }
                    if (prompt && pn >= 4 && pn < 6) {
                        const int b = row >> 11, t = row & 2047;
                        const float dec = fexp2((float)(127 - (t & 127)) * lg2gamma(h));
                        bf16_t* kp = KTD + pf_index(b, h, t, d0);
#pragma unroll
                        for (int j = 0; j < 4; ++j) { kp[j * 32] = f2bf(v0[j] * dec); kp[(64 + j) * 32] = f2bf(v1[j] * dec); }
                    }
                    if (prompt && pn >= 6 && pn < 8) {
                        const int b = row >> 11, t = row & 2047;
                        bf16_t* vp = VT + pf_index(b, h, t, d0);
#pragma unroll
                        for (int j = 0; j < 4; ++j) { vp[j * 32] = f2bf(v0[j]); vp[(64 + j) * 32] = f2bf(v1[j]); }
                    }
                    if (pn < 2) {
                        if (prompt) { const int b = row >> 11, t = row & 2047;
                            if (t >= 2033) { float* pp = poolPg + ((size_t)(b * 15 + (t - 2033))) * 512 + colb + d0; *(f32x4*)pp = v0; *(f32x4*)(pp + 64) = v1; } }
                        else { const int sb = (row - NP) >> 3, ts = row & 7;
                            float* pp = poolSg + ((size_t)(sb * 15 + 7 + ts)) * 512 + colb + d0; *(f32x4*)pp = v0; *(f32x4*)(pp + 64) = v1; }
                    }
                }
                asm volatile("" ::: "memory");
            }
    }
};

template <class Epi, class Sched>
__device__ __forceinline__ void gemm_phase(LAS unsigned char* lds, const Gemm g, const Sched& S, const Epi& E) {
    const int tid = otid(), wid = __builtin_amdgcn_readfirstlane(tid >> 6), lane = tid & 63, wr = wid >> 2, wc = wid & 3, fr = lane & 15, fq = lane >> 4;
    const int K = g.K, nt = K / BK;
    unsigned voffA[2], voffB[2];
#pragma unroll
    for (int i = 0; i < 2; ++i) { int R, C; stage_rc(tid * 16 + i * 8192, R, C); const int Rb = Epi::bperm(R);
        voffA[i] = (unsigned)(R * K + C) * 2u; voffB[i] = (unsigned)(Rb * K + C) * 2u; }
    const size_t kstep = (size_t)(BK * 2);
    const size_t hstep = (size_t)HALF * K * 2;
    const size_t tstep = 2 * hstep;
    const unsigned ldsw = (unsigned)wid * 1024u;
    const int aoff = lds_byte(wr * 64 + fr, fq * 8), boff = lds_byte(wc * 32 + fr, fq * 8);
#define PG8_SA(b, h) (((b) * 2 + (h)) * HTB)
#define PG8_SB(b, h) ((4 + (b) * 2 + (h)) * HTB)
#define PG8_STAGE(bufoff, gbase, voff) do { _Pragma("unroll") for (int _i = 0; _i < 2; ++_i) \
        __builtin_amdgcn_global_load_lds((const unsigned*)((const char*)(gbase) + (voff)[_i]), (LAS unsigned*)(lds + (bufoff) + ldsw + _i * 8192), 16, 0, 0); } while (0)
#define PG8_LDA(dst, b, h) do { _Pragma("unroll") for (int m = 0; m < 4; ++m) _Pragma("unroll") for (int k = 0; k < 2; ++k) dst[m][k] = *(const LAS bf16x8*)(lds + PG8_SA(b, h) + aoff + m * 2048 + k * 1024); } while (0)
#define PG8_LDB(dst, b, h) do { _Pragma("unroll") for (int n = 0; n < 2; ++n) _Pragma("unroll") for (int k = 0; k < 2; ++k) dst[n][k] = *(const LAS bf16x8*)(lds + PG8_SB(b, h) + boff + n * 2048 + k * 1024); } while (0)
#define PG8_MMA(ai, bj, At, Bt) do { __builtin_amdgcn_s_setprio(1); _Pragma("unroll") for (int m = 0; m < 4; ++m) _Pragma("unroll") for (int n = 0; n < 2; ++n) _Pragma("unroll") for (int k = 0; k < 2; ++k) \
        acc[ai][bj][m][n] = __builtin_amdgcn_mfma_f32_16x16x32_bf16(Bt[n][k], At[m][k], acc[ai][bj][m][n], 0, 0, 0); __builtin_amdgcn_s_setprio(0); } while (0)
#define PG8_WAIT_V(n) asm volatile("s_waitcnt vmcnt(" #n ")" ::: "memory")
#define PG8_WAIT_L(n) asm volatile("s_waitcnt lgkmcnt(" #n ")" ::: "memory")
#define PG8_BAR __builtin_amdgcn_s_barrier()
#define PG8_SCHED __builtin_amdgcn_sched_barrier(0)
    Unit cur, nxt; int ui = 0;
    if (!S.next(0, cur)) return;
    f32x4 acc[2][2][4][2];
#pragma unroll
    for (int a = 0; a < 2; ++a)
#pragma unroll
        for (int b = 0; b < 2; ++b)
#pragma unroll
            for (int m = 0; m < 4; ++m)
#pragma unroll
                for (int n = 0; n < 2; ++n) acc[a][b][m][n] = (f32x4){0.f, 0.f, 0.f, 0.f};
    bf16x8 At[4][2], B0[2][2], B1[2][2];
    const char* cA = (const char*)g.A + (size_t)cur.pm * tstep; const char* cB = (const char*)g.Bt + (size_t)cur.pn * tstep;
    S.a_ready(cur);
    PG8_STAGE(PG8_SB(0, 0), cB, voffB); PG8_STAGE(PG8_SA(0, 0), cA, voffA); PG8_STAGE(PG8_SB(0, 1), cB + hstep, voffB); PG8_STAGE(PG8_SA(0, 1), cA + hstep, voffA);
    if (wr == 1) PG8_BAR;
    PG8_WAIT_V(4); PG8_BAR;
    PG8_STAGE(PG8_SB(1, 0), cB + kstep, voffB); PG8_STAGE(PG8_SA(1, 0), cA + kstep, voffA); PG8_STAGE(PG8_SB(1, 1), cB + hstep + kstep, voffB);
    PG8_WAIT_V(6); PG8_BAR;
    for (;;) {
        const bool has_next = S.next(ui + 1, nxt);
        const char* nA = has_next ? (const char*)g.A + (size_t)nxt.pm * tstep : cA; const char* nB = has_next ? (const char*)g.Bt + (size_t)nxt.pn * tstep : cB;
        for (int t = 0; t < nt; t += 2) {
            const bool last = (t == nt - 2);
            const char* a1 = cA + (size_t)(t + 1) * kstep;
            const char* a2 = last ? nA : cA + (size_t)(t + 2) * kstep; const char* b2 = last ? nB : cB + (size_t)(t + 2) * kstep;
            const char* a3 = a2 + kstep; const char* b3 = b2 + kstep;
            if (last && has_next) S.a_ready(nxt);
            PG8_LDB(B0, 0, 0); PG8_SCHED; PG8_LDA(At, 0, 0); PG8_STAGE(PG8_SA(1, 1), a1 + hstep, voffA);
            PG8_WAIT_L(8); PG8_BAR; PG8_WAIT_L(0); PG8_MMA(0, 0, At, B0); PG8_BAR; PG8_SCHED;
            PG8_LDB(B1, 0, 1); PG8_STAGE(PG8_SB(0, 0), b2, voffB);
            PG8_BAR; PG8_WAIT_L(0); PG8_MMA(0, 1, At, B1); PG8_BAR;
            PG8_LDA(At, 0, 1); PG8_STAGE(PG8_SA(0, 0), a2, voffA);
            PG8_BAR; PG8_WAIT_L(0); PG8_MMA(1, 0, At, B0); PG8_BAR; PG8_SCHED;
            PG8_STAGE(PG8_SB(0, 1), b2 + hstep, voffB);
            PG8_WAIT_V(6); PG8_BAR; PG8_MMA(1, 1, At, B1); PG8_BAR;
            PG8_LDB(B0, 1, 0); PG8_SCHED; PG8_LDA(At, 1, 0); PG8_STAGE(PG8_SA(0, 1), a2 + hstep, voffA);
            PG8_WAIT_L(8); PG8_BAR; PG8_WAIT_L(0); PG8_MMA(0, 0, At, B0); PG8_BAR; PG8_SCHED;
            PG8_LDB(B1, 1, 1); PG8_STAGE(PG8_SB(1, 0), b3, voffB);
            PG8_BAR; PG8_WAIT_L(0); PG8_MMA(0, 1, At, B1); PG8_BAR;
            PG8_LDA(At, 1, 1); PG8_STAGE(PG8_SA(1, 0), a3, voffA);
            PG8_BAR; PG8_WAIT_L(0); PG8_MMA(1, 0, At, B0); PG8_BAR; PG8_SCHED;
            PG8_STAGE(PG8_SB(1, 1), b3 + hstep, voffB);
            PG8_WAIT_V(6); PG8_BAR; PG8_MMA(1, 1, At, B1); PG8_BAR;
        }
        E(acc, cur, wr, wc, fr, fq); S.done(cur);
        if (!has_next) break;
#pragma unroll
        for (int a = 0; a < 2; ++a)
#pragma unroll
            for (int b = 0; b < 2; ++b)
#pragma unroll
                for (int m = 0; m < 4; ++m)
#pragma unroll
                    for (int n = 0; n < 2; ++n) acc[a][b][m][n] = (f32x4){0.f, 0.f, 0.f, 0.f};
        cur = nxt; cA = nA; cB = nB; ++ui;
    }
    PG8_WAIT_V(0);
    if (wr == 0) PG8_BAR;
    PG8_BAR;
#undef PG8_SA
#undef PG8_SB
#undef PG8_STAGE
#undef PG8_LDA
#undef PG8_LDB
#undef PG8_MMA
#undef PG8_WAIT_V
#undef PG8_WAIT_L
#undef PG8_BAR
#undef PG8_SCHED
}
}


#define XB_TMO      128
#define XB_XCNT(j)  (256  + 64 * (j))
#define XB_XSUB(j)  (1280 + 64 * (j))
#define XB_XGEN(j)  (2304 + 64 * (j))
#define XB_TOP      3328
#define XB_TOPGEN   3392
#define XCD_BAR_WORDS 3456
#define XB_SPIN_CAP (1u << 18)
__device__ __forceinline__ unsigned xb_ld(unsigned* p)              { return __hip_atomic_load(p, __ATOMIC_RELAXED, __HIP_MEMORY_SCOPE_AGENT); }
__device__ __forceinline__ unsigned xb_add(unsigned* p, unsigned v) { return __hip_atomic_fetch_add(p, v, __ATOMIC_RELAXED, __HIP_MEMORY_SCOPE_AGENT); }
__device__ __forceinline__ unsigned xb_xcc_id() { return (unsigned)__builtin_amdgcn_s_getreg((3 << 11) | 20) & 0xFu; }
#define XB_SPIN(cond, bar) do { unsigned _sp = 0; while (cond) { __builtin_amdgcn_s_sleep(1); \
    if ((++_sp & 255u) == 0u) { if (xb_ld(&(bar)[XB_TMO])) break; if (_sp > XB_SPIN_CAP) { atomicAdd(&(bar)[XB_TMO], 1u); break; } } } } while (0)
struct XcdBarrier { unsigned* bar; unsigned x; volatile LAS unsigned* st; };
__device__ __forceinline__ XcdBarrier xcd_barrier_post(unsigned* bar, volatile LAS unsigned* st) {
    XcdBarrier b; b.bar = bar; b.x = xb_xcc_id(); b.st = st;
    if (threadIdx.x == 0) (void)xb_add(&bar[XB_XCNT(b.x)], 1u);
    return b;
}
__device__ __forceinline__ void xcd_barrier_complete(unsigned* bar, unsigned x, unsigned& nloc, unsigned& nx) {
    const unsigned G = gridDim.x * gridDim.y * gridDim.z;
    unsigned sum, cnt, mine, sp = 0u;
    for (;;) {
        sum = 0u; cnt = 0u; mine = 0u;
#pragma unroll
        for (unsigned j = 0; j < 16; ++j) { const unsigned c = xb_ld(&bar[XB_XCNT(j)]); sum += c; cnt += (c > 0u) ? 1u : 0u; mine = (j == x) ? c : mine; }
        if (sum == G) break;
        __builtin_amdgcn_s_sleep(1);
        if ((++sp & 255u) == 0u) { if (xb_ld(&bar[XB_TMO])) break; if (sp > XB_SPIN_CAP) { atomicAdd(&bar[XB_TMO], 1u); break; } }
    }
    nloc = mine > 0u ? mine : 1u; nx = cnt > 0u ? cnt : 1u;
}
__device__ __forceinline__ void xcd_barrier(const XcdBarrier& b) {
    asm volatile("s_waitcnt vmcnt(0)" ::: "memory");
    __syncthreads();
    if (threadIdx.x == 0) {
        unsigned* bar = b.bar;
        __builtin_amdgcn_s_waitcnt(0);
        unsigned nloc = b.st[0], nx = b.st[1];
        if (nloc == 0u) { xcd_barrier_complete(bar, b.x, nloc, nx); b.st[0] = nloc; b.st[1] = nx; }
        const unsigned old = xb_add(&bar[XB_XSUB(b.x)], 1u);
        const unsigned gen = old / nloc;
        if (old + 1u == (gen + 1u) * nloc) {
            __builtin_amdgcn_fence(__ATOMIC_RELEASE, "agent");
            asm volatile("s_waitcnt vmcnt(0)" ::: "memory");
            const unsigned og = xb_add(&bar[XB_TOP], 1u);
            const unsigned tg = og / nx;
            if (og + 1u == (tg + 1u) * nx) xb_add(&bar[XB_TOPGEN], 1u);
            else XB_SPIN(xb_ld(&bar[XB_TOPGEN]) == tg, bar);
            __builtin_amdgcn_fence(__ATOMIC_ACQUIRE, "agent");
            xb_add(&bar[XB_XGEN(b.x)], 1u);
            asm volatile("s_waitcnt vmcnt(0)" ::: "memory");
        } else {
            XB_SPIN(xb_ld(&bar[XB_XGEN(b.x)]) == gen, bar);
            __builtin_amdgcn_fence(__ATOMIC_ACQUIRE, "agent");
            asm volatile("s_waitcnt vmcnt(0)" ::: "memory");
        }
    }
    __syncthreads();
}

struct Params {
    const float* x_prompt; const float* x_sample; const float* c_prompt; const float* c_sample;
    const float* state_ret; const float* state_pool; const float* w_ada; const float* b_ada;
    const float* g_pre; const float* g_post; const float* w_in; const float* w_pool; const float* pool_scale; const float* w_o;
    float* out; unsigned char* ws;
};
__device__ __forceinline__ Params gp(const Params& q) { return q; }
constexpr size_t OUT_YP = 0;
constexpr size_t OUT_YS = OUT_YP + (size_t)NP * DM;
constexpr size_t OUT_RETP = OUT_YS + (size_t)NS * DM;
constexpr size_t OUT_POOLP = OUT_RETP + (size_t)DEPTH * NB * 4 * 128 * 128;
constexpr size_t OUT_RETS = OUT_POOLP + (size_t)DEPTH * NB * 15 * 512;
constexpr size_t OUT_POOLS = OUT_RETS + (size_t)DEPTH * SB * 4 * 128 * 128;
constexpr size_t OUT_END = OUT_POOLS + (size_t)DEPTH * SB * 15 * 512;

constexpr int NTHREADS = 512;
constexpr int LDS_USER = 160 * 1024 - 16;
constexpr int LDS_BYTES = 160 * 1024;

struct TcTile { const float* src; bf16_t* dst; int R, C, tr, tc; bool frag; bf16_t* dst2; };
__device__ __forceinline__ TcTile tc_decode(const Params& p_, int t) {
    const Params p = gp(p_);
    unsigned char* const wsb = ows(p.ws);
    bf16_t* WinT = (bf16_t*)(wsb + WS_WIN); bf16_t* WoT = (bf16_t*)(wsb + WS_WO); bf16_t* WadaT = (bf16_t*)(wsb + WS_WADA); bf16_t* WpT = (bf16_t*)(wsb + WS_WPOOL);
    const int T1 = 3072, T2 = 6144, T3 = 7168;
    TcTile x;
    if (t < T1) { const int l = t / 768, r = t % 768; x = TcTile{p.w_in + (size_t)l * DM * DIN, WinT + (size_t)l * DIN * DM, DM, DIN, r / 48, r % 48, false, (bf16_t*)(wsb + WS_WINF) + (size_t)l * DIN * DM}; }
    else if (t < T2) { const int q = t - T1, l = q / 768, r = q % 768; x = TcTile{p.w_ada + (size_t)l * DM * DIN, WadaT + (size_t)l * DIN * DM, DM, DIN, r / 48, r % 48, false, nullptr}; }
    else if (t < T3) { const int q = t - T2, l = q / 256, r = q % 256; x = TcTile{p.w_o + (size_t)l * DM * DM, WoT + (size_t)l * DM * DM, DM, DM, r / 16, r % 16, true, nullptr}; }
    else { const int q = t - T3, m = q / 4, r = q % 4; x = TcTile{p.w_pool + (size_t)m * 128 * 128, WpT + (size_t)m * 128 * 128, 128, 128, r / 2, r % 2, false, nullptr}; }
    return x;
}

__device__ void phase_prep(const Params& p_, LAS unsigned char* lds) {
    const Params p = gp(p_);
    unsigned char* const wsb = ows(p.ws);
    LAS float* tile = (LAS float*)lds;
    const int tid = otid();
    const int T4 = 7232;
    for (int t0 = blockIdx.x * 4; t0 < T4; t0 += gridDim.x * 4) {
        f32x4 va[4], vb[4];
        const int r = tid >> 3, c0 = (tid & 7) * 8;
#pragma unroll
        for (int q = 0; q < 4; ++q) { const TcTile x = tc_decode(p, t0 + q);
            const float* sp = x.src + (size_t)(x.tr * 64 + r) * x.C + x.tc * 64 + c0;
            va[q] = __builtin_nontemporal_load((const f32x4*)sp); vb[q] = __builtin_nontemporal_load((const f32x4*)(sp + 4)); }
#pragma unroll
        for (int q = 0; q < 4; ++q) { LAS float* tl = tile + q * 64 * 65;
#pragma unroll
            for (int k = 0; k < 4; ++k) { tl[(c0 + k) * 65 + r] = va[q][k]; tl[(c0 + 4 + k) * 65 + r] = vb[q][k]; } }
        __syncthreads();
#pragma unroll
        for (int q = 0; q < 4; ++q) { const TcTile x = tc_decode(p, t0 + q); LAS float* tl = tile + q * 64 * 65;
            const int cc = tid >> 3, r8 = (tid & 7) * 8;
            u32x4 wv;
            wv.x = cvt_pk_bf16(tl[cc * 65 + r8 + 0], tl[cc * 65 + r8 + 1]); wv.y = cvt_pk_bf16(tl[cc * 65 + r8 + 2], tl[cc * 65 + r8 + 3]);
            wv.z = cvt_pk_bf16(tl[cc * 65 + r8 + 4], tl[cc * 65 + r8 + 5]); wv.w = cvt_pk_bf16(tl[cc * 65 + r8 + 6], tl[cc * 65 + r8 + 7]);
            const int n = x.tc * 64 + cc, k = x.tr * 64 + r8;
            const size_t di = x.frag ? ((size_t)(((n >> 4) * 32 + (k >> 5)) * 64 + (((k >> 3) & 3) * 16 + (n & 15)))) * 8 : (size_t)n * x.R + k;
            *(u32x4*)(x.dst + di) = wv;
            if (x.dst2) *(u32x4*)(x.dst2 + ((size_t)(((n >> 4) * 32 + (k >> 5)) * 64 + (((k >> 3) & 3) * 16 + (n & 15)))) * 8) = wv; }
        __syncthreads();
    }
    const int gtid = blockIdx.x * NTHREADS + otid(), gn = gridDim.x * NTHREADS;
    bf16_t* SC = (bf16_t*)(wsb + WS_SC);
    for (int i = gtid; i < 256 * DM; i += gn) { const int r = i >> 10, k = i & 1023;
        float v = 0.f; if (r < NB) v = silu_f(p.c_prompt[r * DM + k]); else if (r < NB + SB) v = silu_f(p.c_sample[(r - NB) * DM + k]);
        SC[i] = f2bf(v); }
    float* cosT = (float*)(wsb + WS_COS); float* sinT = (float*)(wsb + WS_SIN);
    for (int i = gtid; i < 2056 * 64; i += gn) { const int tp = i >> 6, f = i & 63;
        const float pos = (float)(tp < 2048 ? tp : (16384 + tp - 2048));
        const float inv = 1.0f / powf(10000.0f, (float)f * (1.0f / 64.0f));
        const float ang = pos * inv;
        const double a = (double)ang; const double kq = rint(a * 0.63661977236758134308); const double r = a - kq * 1.57079632679489661923;
        const double r2 = r * r;
        const double sn = r * (1.0 + r2 * (-1.0 / 6 + r2 * (1.0 / 120 + r2 * (-1.0 / 5040 + r2 * (1.0 / 362880 + r2 * (-1.0 / 39916800))))));
        const double cs = 1.0 + r2 * (-0.5 + r2 * (1.0 / 24 + r2 * (-1.0 / 720 + r2 * (1.0 / 40320 + r2 * (-1.0 / 3628800 + r2 * (1.0 / 479001600))))));
        const int qd = ((int)(long long)kq) & 3;
        double c, s; if (qd == 0) { c = cs; s = sn; } else if (qd == 1) { c = -sn; s = cs; } else if (qd == 2) { c = -cs; s = -sn; } else { c = sn; s = -cs; }
        cosT[i] = (float)c; sinT[i] = (float)s; }
}

__device__ void phase_rows(const Params& p_, int l_prev, int l_next, int row_lo, int row_hi) {
    const Params p = gp(p_);
    unsigned char* const wsb = ows(p.ws);
    const int tid0 = otid(); const int wave = tid0 >> 6, lane = tid0 & 63;
    const float* mod = (const float*)(wsb + WS_MOD); const float* Y = (const float*)(wsb + WS_Y);
    float* XR = (float*)(wsb + WS_XR); bf16_t* H = (bf16_t*)(wsb + WS_H);
    for (int row = row_lo + blockIdx.x * 8 + wave; row < row_hi; row += gridDim.x * 8) {
        const int brow = row < NP ? (row >> 11) : (NB + ((row - NP) >> 3));
        const float* xin = (l_prev <= 0) ? (row < NP ? p.x_prompt + (size_t)row * DM : p.x_sample + (size_t)(row - NP) * DM) : XR + (size_t)row * DM;
        f32x4 x[4];
#pragma unroll
        for (int j = 0; j < 4; ++j) x[j] = __builtin_nontemporal_load((const f32x4*)(xin + lane * 4 + j * 256));
        if (l_prev >= 0) {
            f32x4 y[4]; float ss = 0.f;
#pragma unroll
            for (int j = 0; j < 4; ++j) { y[j] = __builtin_nontemporal_load((const f32x4*)(Y + (size_t)row * DM + lane * 4 + j * 256)); ss += y[j][0] * y[j][0] + y[j][1] * y[j][1] + y[j][2] * y[j][2] + y[j][3] * y[j][3]; }
            ss = wave_sum(ss); const float rstd = rsqrtf(ss * (1.0f / DM) + EPSN);
            float* xo = (l_prev == DEPTH - 1) ? p.out + (size_t)row * DM : XR + (size_t)row * DM;
#pragma unroll
            for (int j = 0; j < 4; ++j) { const int col = lane * 4 + j * 256;
                const f32x4 gr = *(const f32x4*)(mod + (size_t)brow * MODLD + l_prev * 3072 + 2048 + col), gp = *(const f32x4*)(p.g_post + l_prev * DM + col);
                x[j] = x[j] + gr * (y[j] * rstd * gp); *(f32x4*)(xo + col) = x[j]; }
        }
        if (l_next < DEPTH) {
            float ss = 0.f;
#pragma unroll
            for (int j = 0; j < 4; ++j) ss += x[j][0] * x[j][0] + x[j][1] * x[j][1] + x[j][2] * x[j][2] + x[j][3] * x[j][3];
            ss = wave_sum(ss); const float rstd = rsqrtf(ss * (1.0f / DM) + EPSN);
#pragma unroll
            for (int j = 0; j < 4; ++j) { const int col = lane * 4 + j * 256;
                const f32x4 sh = *(const f32x4*)(mod + (size_t)brow * MODLD + l_next * 3072 + col), sc = *(const f32x4*)(mod + (size_t)brow * MODLD + l_next * 3072 + 1024 + col), gp = *(const f32x4*)(p.g_pre + l_next * DM + col);
                const f32x4 hv = x[j] * rstd * gp * (1.0f + sc) + sh;
                u32x2 w; w.x = cvt_pk_bf16(hv[0], hv[1]); w.y = cvt_pk_bf16(hv[2], hv[3]);
                if (row < NP) *(u32x2*)(H + (size_t)row * DM + col) = w;
                else *(u32x2*)((bf16_t*)(wsb + WS_HSF) + mixf_index((size_t)(row - NP), col)) = w; }
        }
    }
}

__device__ void kvscan_task(const Params& p_, int l, int task, LAS unsigned char* lds) {
    const Params p = gp(p_);
    unsigned char* const wsb = ows(p.ws);
    const int tid0 = otid(); const int wave = __builtin_amdgcn_readfirstlane(tid0 >> 6), lane = tid0 & 63, q4 = lane >> 4, lr = lane & 15;
    const int bh = task >> 3, es = task & 7, h = bh & 3, b = bh >> 2;
    const bf16_t* KTD = (const bf16_t*)(wsb + WS_KTD); const bf16_t* VT = (const bf16_t*)(wsb + WS_VT); bf16_t* SPT = (bf16_t*)(wsb + WS_SPT);
    const bf16_t* ka = KTD + (size_t)bh * 16 * 4 * 128 * 32 + (16 * wave + lr) * 32 + 8 * q4;
    const float g128 = fexp2(128.0f * lg2gamma(h));
    f32x4 S = {0.f, 0.f, 0.f, 0.f};
    const int e = 16 * es + lr, d0 = 16 * wave + 4 * q4;
    {
        u32x4 vv[8];
#pragma unroll
        for (int k = 0; k < 8; ++k) { const int pi = tid0 + k * NTHREADS; vv[k] = *(const u32x4*)(VT + (size_t)bh * 16 * 4 * 128 * 32 + (size_t)(pi >> 6) * 4096 + es * 512 + (pi & 63) * 8); }
#pragma unroll
        for (int k = 0; k < 8; ++k) { const int pi = tid0 + k * NTHREADS; *(LAS u32x4*)(lds + pi * 16) = vv[k]; }
        __syncthreads();
    }
    bf16x8 fa[2][4], fb[2][4];
#define KV_LOAD(s_, n_) do { _Pragma("unroll") for (int ks = 0; ks < 4; ++ks) { fa[s_][ks] = *(const bf16x8*)(ka + ((n_) * 4 + ks) * 4096); fb[s_][ks] = *(const LAS bf16x8*)(lds + ((n_) * 4 + ks) * 1024 + (lr * 4 + q4) * 16); } } while (0)
#define KV_STEP(s_, n_) do { f32x4 kv = {0.f, 0.f, 0.f, 0.f}; \
        _Pragma("unroll") for (int ks = 0; ks < 4; ++ks) kv = __builtin_amdgcn_mfma_f32_16x16x32_bf16(fa[s_][ks], fb[s_][ks], kv, 0, 0, 0); \
        u32x2 wv; wv.x = cvt_pk_bf16(S[0], S[1]); wv.y = cvt_pk_bf16(S[2], S[3]); \
        *(u32x2*)(SPT + ((size_t)((((((b * 16 + (n_)) * 4 + h) * 8 + es) * 4 + (wave >> 1)) * 64) + (((2 * wave + (q4 >> 1)) & 3) * 16 + lr))) * 8 + 4 * (q4 & 1)) = wv; \
        S = S * g128 + kv; } while (0)
    KV_LOAD(0, 0);
#pragma unroll
    for (int n = 0; n < 16; n += 2) {
        KV_LOAD(1, n + 1);
        __builtin_amdgcn_sched_barrier(0);
        KV_STEP(0, n);
        __builtin_amdgcn_sched_barrier(0);
        if (n + 2 < 16) KV_LOAD(0, n + 2);
        __builtin_amdgcn_sched_barrier(0);
        KV_STEP(1, n + 1);
        __builtin_amdgcn_sched_barrier(0);
    }
#undef KV_LOAD
#undef KV_STEP
    float* rp = p.out + OUT_RETP + ((size_t)((l * NB + b) * 4 + h)) * 16384;
#pragma unroll
    for (int r = 0; r < 4; ++r) rp[(d0 + r) * 128 + e] = S[r];
    __syncthreads();
}

__device__ void rs_task(const Params& p_, int l, int task, LAS unsigned char* lds) {
    const Params p = gp(p_);
    unsigned char* const wsb = ows(p.ws);
    const int tid = otid(), w = __builtin_amdgcn_readfirstlane(tid >> 6), lane = tid & 63, q4 = lane >> 4, lr = lane & 15, b = task >> 2, h = task & 3;
    const bf16_t* ZB = (const bf16_t*)(wsb + WS_ZB); bf16_t* MIX = (bf16_t*)(wsb + WS_MIX);
    LAS float* qT = (LAS float*)lds;
    LAS float* kT = qT + 1024;
    LAS float* kdT = kT + 1024;
    LAS float* vS = kdT + 1024;
    LAS float* sc = vS + 1024;
    LAS float* red = sc + 64;
    LAS float* uF = red + 16 * 8 * 128;
    LAS float* mS = uF + 23 * 128;
    const float lg = lg2gamma(h);
    const size_t r0 = (size_t)NP + b * 8;
    const int g = h, win = 2 << g;
    const float* S0 = p.state_ret + ((size_t)((l * SB + b) * 4 + h)) * 16384;
    float* S1 = p.out + OUT_RETS + ((size_t)((l * SB + b) * 4 + h)) * 16384;
    const int e4 = (tid & 31) * 4, dg = tid >> 5;
    f32x4 s0[8];
#pragma unroll
    for (int dd = 0; dd < 8; ++dd) s0[dd] = __builtin_nontemporal_load((const f32x4*)(S0 + (dg * 8 + dd) * 128 + e4));
    const int li = tid >> 6, ld2 = (tid & 63) * 2;
    const unsigned qv = __builtin_nontemporal_load((const unsigned*)(ZB + (r0 + li) * DIN + 512 + h * 128 + ld2)), kv = __builtin_nontemporal_load((const unsigned*)(ZB + (r0 + li) * DIN + 1024 + h * 128 + ld2)), vv = __builtin_nontemporal_load((const unsigned*)(ZB + (r0 + li) * DIN + 1536 + h * 128 + ld2));
    f32x4 hist = {0.f, 0.f, 0.f, 0.f}; u32x2 ucur = {0u, 0u};
    if (tid < 480) hist = __builtin_nontemporal_load((const f32x4*)(p.state_pool + ((size_t)(l * SB + b) * 15 + (tid >> 5)) * 512 + g * 128 + (tid & 31) * 4));
    if (tid < 256) ucur = *(const u32x2*)(ZB + (r0 + (tid >> 5)) * DIN + g * 128 + (tid & 31) * 4);
    const bf16_t gr0 = ZB[(r0 + li) * DIN + 2560 + h * 128 + lane], gr1 = ZB[(r0 + li) * DIN + 2560 + h * 128 + lane + 64];
    const bf16_t* WpT = (const bf16_t*)(wsb + WS_WPOOL) + (size_t)(l * 4 + g) * 16384;
    bf16x8 wf[4];
#pragma unroll
    for (int ks = 0; ks < 4; ++ks) wf[ks] = *(const bf16x8*)(WpT + (size_t)(16 * w + lr) * 128 + ks * 32 + 8 * q4);
    const int pcol = g * 128 + 16 * w + 4 * q4;
    const f32x4 psc = *(const f32x4*)(p.pool_scale + l * 512 + pcol);
    u32x2 gpq = {0u, 0u}; if (lr < 8) gpq = *(const u32x2*)(ZB + (r0 + lr) * DIN + 2048 + pcol);
    float cp[7];
    if (h == 0) {
#pragma unroll
        for (int k = 0; k < 7; ++k) cp[k] = p.state_pool[((size_t)(l * SB + b) * 15 + 8) * 512 + tid + k * NTHREADS];
    }
    __builtin_amdgcn_sched_barrier(0);
    { const float kd = fexp2((float)(7 - li) * lg);
      qT[ld2 * 8 + li] = __uint_as_float(qv << 16); qT[(ld2 + 1) * 8 + li] = __uint_as_float(qv & 0xffff0000u);
      const float k0 = __uint_as_float(kv << 16), k1 = __uint_as_float(kv & 0xffff0000u);
      kT[ld2 * 8 + li] = k0; kT[(ld2 + 1) * 8 + li] = k1; kdT[ld2 * 8 + li] = k0 * kd; kdT[(ld2 + 1) * 8 + li] = k1 * kd;
      vS[li * 128 + ld2] = __uint_as_float(vv << 16); vS[li * 128 + ld2 + 1] = __uint_as_float(vv & 0xffff0000u);
      if (tid < 480) *(LAS f32x4*)(uF + (tid >> 5) * 128 + (tid & 31) * 4) = hist;
      if (tid < 256) *(LAS f32x4*)(uF + (15 + (tid >> 5)) * 128 + (tid & 31) * 4) = (f32x4){__uint_as_float(ucur.x << 16), __uint_as_float(ucur.x & 0xffff0000u), __uint_as_float(ucur.y << 16), __uint_as_float(ucur.y & 0xffff0000u)};
      mS[1024 + tid] = 0.f; mS[1536 + tid] = 0.f; }
    __syncthreads();
    {
      const int pr = tid >> 3, i = pr >> 3, j = pr & 7, dp = tid & 7; float sv = 0.f;
#pragma unroll
      for (int d = dp * 16; d < dp * 16 + 16; ++d) sv += qT[d * 8 + i] * kT[d * 8 + j];
      sv += __shfl_xor(sv, 1); sv += __shfl_xor(sv, 2); sv += __shfl_xor(sv, 4);
      if (dp == 0) sc[pr] = (j <= i) ? sv * fexp2((float)(i - j) * lg) : 0.f; }
    {
      const int c = tid & 127, tq = tid >> 7; const float rw = 1.0f / (float)win;
#pragma unroll
      for (int k2 = 0; k2 < 2; ++k2) { const int ts = 2 * tq + k2; float sm = 0.f;
          for (int k = 0; k < win; ++k) sm += uF[(15 + ts - k) * 128 + c];
          mS[ts * 128 + c] = sm * rw - uF[(15 + ts) * 128 + c]; } }
    {
        const float g8 = fexp2(8.0f * lg);
        f32x4 cr[8], vj[8];
#pragma unroll
        for (int i = 0; i < 8; ++i) { cr[i] = (f32x4){0.f, 0.f, 0.f, 0.f}; vj[i] = *(const LAS f32x4*)(vS + i * 128 + e4); }
#pragma unroll
        for (int dd = 0; dd < 8; ++dd) { const int d = dg * 8 + dd;
            const f32x4 qa = *(const LAS f32x4*)(qT + d * 8), qb = *(const LAS f32x4*)(qT + d * 8 + 4), ka = *(const LAS f32x4*)(kdT + d * 8), kb = *(const LAS f32x4*)(kdT + d * 8 + 4);
            f32x4 sf = s0[dd] * g8;
#pragma unroll
            for (int i = 0; i < 4; ++i) { cr[i] += s0[dd] * qa[i]; cr[4 + i] += s0[dd] * qb[i]; sf += vj[i] * ka[i]; sf += vj[4 + i] * kb[i]; }
            __builtin_nontemporal_store(sf, (f32x4*)(S1 + d * 128 + e4)); }
#pragma unroll
        for (int i = 0; i < 8; ++i) *(LAS f32x4*)(red + (dg * 8 + i) * 128 + e4) = cr[i];
    }
    __syncthreads();
    { const int i = li; float o[2]; float ss = 0.f;
#pragma unroll
      for (int k = 0; k < 2; ++k) { const int e = lane + 64 * k;
          float cross = 0.f;
#pragma unroll
          for (int d2 = 0; d2 < 16; ++d2) cross += red[(d2 * 8 + i) * 128 + e];
          float v = fexp2((float)(i + 1) * lg) * cross;
#pragma unroll
          for (int j = 0; j < 8; ++j) v += sc[i * 8 + j] * vS[j * 128 + e];
          o[k] = v; ss += v * v; }
      ss = wave_sum(ss); const float rstd = rsqrtf(ss * (1.0f / 128.0f) + EPSN);
      MIX[(r0 + i) * DM + 512 + h * 128 + lane] = f2bf(o[0] * rstd * silu_f(bf2f(gr0)));
      MIX[(r0 + i) * DM + 512 + h * 128 + lane + 64] = f2bf(o[1] * rstd * silu_f(bf2f(gr1))); }
    {
        f32x4 acc = {0.f, 0.f, 0.f, 0.f};
#pragma unroll
        for (int ks = 0; ks < 4; ++ks) { const f32x4 m0 = *(const LAS f32x4*)(mS + lr * 128 + ks * 32 + 8 * q4), m1 = *(const LAS f32x4*)(mS + lr * 128 + ks * 32 + 8 * q4 + 4);
            const bf16x8 mf = __builtin_bit_cast(bf16x8, (u32x4){cvt_pk_bf16(m0[0], m0[1]), cvt_pk_bf16(m0[2], m0[3]), cvt_pk_bf16(m1[0], m1[1]), cvt_pk_bf16(m1[2], m1[3])});
            acc = __builtin_amdgcn_mfma_f32_16x16x32_bf16(wf[ks], mf, acc, 0, 0, 0); }
        if (lr < 8) { const float g0 = __uint_as_float(gpq.x << 16), g1 = __uint_as_float(gpq.x & 0xffff0000u), g2 = __uint_as_float(gpq.y << 16), g3 = __uint_as_float(gpq.y & 0xffff0000u);
            u32x2 o; o.x = cvt_pk_bf16(acc[0] * psc[0] * silu_f(g0), acc[1] * psc[1] * silu_f(g1)); o.y = cvt_pk_bf16(acc[2] * psc[2] * silu_f(g2), acc[3] * psc[3] * silu_f(g3));
            *(u32x2*)(MIX + (r0 + lr) * DM + pcol) = o; }
    }
    if (h == 0) {
        float* dp = p.out + OUT_POOLS + ((size_t)(l * SB + b) * 15) * 512;
#pragma unroll
        for (int k = 0; k < 7; ++k) dp[tid + k * NTHREADS] = cp[k];
    }
    __syncthreads();
}

template <int NPAIR>
__device__ __forceinline__ void retention_part(const Params& p_, int R0, int w, int q4, int lr) {
    const Params p = gp(p_);
    unsigned char* const wsb = ows(p.ws);
    const int lane = q4 * 16 + lr;
    const bf16_t* QF = (const bf16_t*)(wsb + WS_QF); const bf16_t* KF = (const bf16_t*)(wsb + WS_KF);
    const bf16_t* G2 = (const bf16_t*)(wsb + WS_G2); bf16_t* MIX = (bf16_t*)(wsb + WS_MIX);
    const bf16_t* VT = (const bf16_t*)(wsb + WS_VT); const bf16_t* SPT = (const bf16_t*)(wsb + WS_SPT);
    const int h = w >> 1, itb = 2 * (w & 1), b = R0 >> 11, n = (R0 & 2047) >> 7, itg0 = 4 * (NPAIR / 2 - 1) + itb;
    const size_t t0 = (size_t)(R0 & ~127);
    const float lg = lg2gamma(h);
    bf16x8 qf[2][4];
#pragma unroll
    for (int i2 = 0; i2 < 2; ++i2) { const bf16_t* qp = QF + ((size_t)((((R0 >> 4) + itb + i2) * 4 + h) * 4) * 64 + lane) * 8;
#pragma unroll
        for (int ks = 0; ks < 4; ++ks) qf[i2][ks] = __builtin_nontemporal_load((const bf16x8*)(qp + ks * 512)); }
    f32x4 acc[2][8];
#pragma unroll
    for (int i2 = 0; i2 < 2; ++i2)
#pragma unroll
        for (int et = 0; et < 8; ++et) acc[i2][et] = (f32x4){0.f, 0.f, 0.f, 0.f};
#pragma unroll
    for (int eq = 0; eq < 4; ++eq) {
        bf16x8 sf[2][4];
#pragma unroll
        for (int e2 = 0; e2 < 2; ++e2) { const bf16_t* sp = SPT + ((size_t)(((((b * 16 + n) * 4 + h) * 8 + eq * 2 + e2) * 4) * 64) + lane) * 8;
#pragma unroll
            for (int ks = 0; ks < 4; ++ks) sf[e2][ks] = *(const bf16x8*)(sp + ks * 512); }
        __builtin_amdgcn_sched_barrier(0);
#pragma unroll
        for (int e2 = 0; e2 < 2; ++e2)
#pragma unroll
            for (int ks = 0; ks < 4; ++ks) {
                acc[0][eq * 2 + e2] = __builtin_amdgcn_mfma_f32_16x16x32_bf16(sf[e2][ks], qf[0][ks], acc[0][eq * 2 + e2], 0, 0, 0);
                acc[1][eq * 2 + e2] = __builtin_amdgcn_mfma_f32_16x16x32_bf16(sf[e2][ks], qf[1][ks], acc[1][eq * 2 + e2], 0, 0, 0); }
    }
#pragma unroll
    for (int i2 = 0; i2 < 2; ++i2) { const float dec = fexp2((float)(16 * (itg0 + i2) + lr + 1) * lg);
#pragma unroll
        for (int et = 0; et < 8; ++et) acc[i2][et] *= dec; }
#pragma unroll
    for (int jp = 0; jp < NPAIR; ++jp) {
        if (2 * jp <= itg0 + 1) {
            bf16x8 kf[2][4], vf[8];
#pragma unroll
            for (int hf = 0; hf < 2; ++hf) { const bf16_t* kp = KF + ((size_t)((((t0 >> 4) + 2 * jp + hf) * 4 + h) * 4) * 64 + lane) * 8;
#pragma unroll
                for (int ks = 0; ks < 4; ++ks) kf[hf][ks] = *(const bf16x8*)(kp + ks * 512); }
#pragma unroll
            for (int et = 0; et < 8; ++et) vf[et] = *(const bf16x8*)(VT + ((size_t)((((b * 4 + h) * 16 + n) * 4 + jp) * 128 + 16 * et + lr)) * 32 + 8 * q4);
            __builtin_amdgcn_sched_barrier(0);
#pragma unroll
            for (int i2 = 0; i2 < 2; ++i2) {
                const int itg = itg0 + i2;
                if (2 * jp <= itg) {
                    unsigned pw[4];
#pragma unroll
                    for (int hf = 0; hf < 2; ++hf) {
                        f32x4 sacc = {0.f, 0.f, 0.f, 0.f};
#pragma unroll
                        for (int ks = 0; ks < 4; ++ks) sacc = __builtin_amdgcn_mfma_f32_16x16x32_bf16(kf[hf][ks], qf[i2][ks], sacc, 0, 0, 0);
                        float pv[4];
#pragma unroll
                        for (int r = 0; r < 4; ++r) { const int diff = (16 * itg + lr) - (16 * (2 * jp + hf) + 4 * q4 + r); pv[r] = (diff >= 0) ? sacc[r] * fexp2((float)diff * lg) : 0.f; }
                        pw[2 * hf] = cvt_pk_bf16(pv[0], pv[1]); pw[2 * hf + 1] = cvt_pk_bf16(pv[2], pv[3]);
                    }
                    const bf16x8 P = __builtin_bit_cast(bf16x8, (u32x4){pw[0], pw[1], pw[2], pw[3]});
#pragma unroll
                    for (int et = 0; et < 8; ++et) acc[i2][et] = __builtin_amdgcn_mfma_f32_16x16x32_bf16(vf[et], P, acc[i2][et], 0, 0, 0);
                }
            }
        }
    }
#pragma unroll
    for (int i2 = 0; i2 < 2; ++i2) {
        const size_t row = (size_t)R0 + 16 * (itb + i2) + lr;
        u32x2 gqv[8];
#pragma unroll
        for (int et = 0; et < 8; ++et) gqv[et] = __builtin_nontemporal_load((const u32x2*)(G2 + g2_index(row, 512 + h * 128 + 16 * et + 4 * q4)));
        float ss = 0.f;
#pragma unroll
        for (int et = 0; et < 8; ++et)
#pragma unroll
            for (int r = 0; r < 4; ++r) ss += acc[i2][et][r] * acc[i2][et][r];
        ss += __shfl_xor(ss, 16); ss += __shfl_xor(ss, 32);
        const float rstd = rsqrtf(ss * (1.0f / 128.0f) + EPSN);
#pragma unroll
        for (int et = 0; et < 8; ++et) { const int col = 512 + h * 128 + 16 * et + 4 * q4;
            const u32x2 gg = gqv[et];
            const float g0 = __uint_as_float(gg.x << 16), g1 = __uint_as_float(gg.x & 0xffff0000u), g2 = __uint_as_float(gg.y << 16), g3 = __uint_as_float(gg.y & 0xffff0000u);
            u32x2 o; o.x = cvt_pk_bf16(acc[i2][et][0] * rstd * silu_f(g0), acc[i2][et][1] * rstd * silu_f(g1)); o.y = cvt_pk_bf16(acc[i2][et][2] * rstd * silu_f(g2), acc[i2][et][3] * rstd * silu_f(g3));
            *(u32x2*)(MIX + mixf_index(row, col)) = o; }
    }
}

__device__ void mixer_task(const Params& p_, int l, int tile, LAS unsigned char* lds) {
    const Params p = gp(p_);
    unsigned char* const wsb = ows(p.ws);
    const int tid = otid(), w = __builtin_amdgcn_readfirstlane(tid >> 6), lane = tid & 63, q4 = lane >> 4, lr = lane & 15;
    const int R0 = tile * 64;
    const bf16_t* ZB = (const bf16_t*)(wsb + WS_ZB); bf16_t* MIX = (bf16_t*)(wsb + WS_MIX);
    LAS bf16_t* U = (LAS bf16_t*)lds;
    LAS bf16_t* Mm = (LAS bf16_t*)(lds + 80896);
    {
        const int tl0 = R0 & 2047;
        u32x4 v[10];
#pragma unroll
        for (int k = 0; k < 10; ++k) { const int idx = tid + k * NTHREADS, rr = idx >> 6, c8 = (idx & 63) * 8;
            v[k] = (u32x4){0u, 0u, 0u, 0u};
            if (idx < 79 * 64 && tl0 - 15 + rr >= 0) v[k] = __builtin_nontemporal_load((const u32x4*)(ZB + (size_t)(R0 - 15 + rr) * DIN + c8)); }
#pragma unroll
        for (int k = 0; k < 10; ++k) { const int idx = tid + k * NTHREADS, rr = idx >> 6, c8 = (idx & 63) * 8;
            if (idx < 79 * 64) *(LAS u32x4*)(U + rr * 512 + c8) = v[k]; }
        __syncthreads();
        const int c = tid, win = 2 << (c >> 7);
        float s = 0.f;
        for (int k = 1; k < win; ++k) s += bf2f(U[(15 - k) * 512 + c]);
#pragma unroll 8
        for (int ii = 0; ii < 64; ++ii) { const int tl = tl0 + ii;
            const float cur = bf2f(U[(15 + ii) * 512 + c]); s += cur;
            const int cnt = (tl + 1 < win) ? (tl + 1) : win;
            Mm[ii * 520 + c] = f2bf(s * __builtin_amdgcn_rcpf((float)cnt) - cur);
            s -= bf2f(U[(15 + ii - (win - 1)) * 512 + c]); }
        __syncthreads();
        const int g = w >> 1;
        const bf16_t* WpT = (const bf16_t*)(wsb + WS_WPOOL) + (size_t)(l * 4 + g) * 16384;
        bf16x8 af[2][4];
#pragma unroll
        for (int m2 = 0; m2 < 2; ++m2)
#pragma unroll
            for (int ks = 0; ks < 4; ++ks) af[m2][ks] = *(const LAS bf16x8*)(Mm + (16 * (2 * (w & 1) + m2) + lr) * 520 + g * 128 + ks * 32 + 8 * q4);
#pragma unroll
        for (int nh = 0; nh < 2; ++nh) {
            bf16x8 bfr[4][4]; u32x2 gq[2][4]; f32x4 psc[4];
#pragma unroll
            for (int n2 = 0; n2 < 4; ++n2) { const bf16_t* bp = WpT + (size_t)(16 * (nh * 4 + n2) + lr) * 128 + 8 * q4;
#pragma unroll
                for (int ks = 0; ks < 4; ++ks) bfr[n2][ks] = *(const bf16x8*)(bp + ks * 32);
                const int col = g * 128 + 16 * (nh * 4 + n2) + 4 * q4;
                psc[n2] = *(const f32x4*)(p.pool_scale + l * 512 + col);
#pragma unroll
                for (int m2 = 0; m2 < 2; ++m2) gq[m2][n2] = __builtin_nontemporal_load((const u32x2*)((const bf16_t*)(wsb + WS_G2) + g2_index((size_t)R0 + 16 * (2 * (w & 1) + m2) + lr, col))); }
            __builtin_amdgcn_sched_barrier(0);
#pragma unroll
            for (int m2 = 0; m2 < 2; ++m2)
#pragma unroll
                for (int n2 = 0; n2 < 4; ++n2) {
                    f32x4 acc = {0.f, 0.f, 0.f, 0.f};
#pragma unroll
                    for (int ks = 0; ks < 4; ++ks) acc = __builtin_amdgcn_mfma_f32_16x16x32_bf16(bfr[n2][ks], af[m2][ks], acc, 0, 0, 0);
                    const size_t row = (size_t)R0 + 16 * (2 * (w & 1) + m2) + lr; const int col = g * 128 + 16 * (nh * 4 + n2) + 4 * q4;
                    const u32x2 gg = gq[m2][n2];
                    const float g0 = __uint_as_float(gg.x << 16), g1 = __uint_as_float(gg.x & 0xffff0000u), g2 = __uint_as_float(gg.y << 16), g3 = __uint_as_float(gg.y & 0xffff0000u);
                    u32x2 o; o.x = cvt_pk_bf16(acc[0] * psc[n2][0] * silu_f(g0), acc[1] * psc[n2][1] * silu_f(g1)); o.y = cvt_pk_bf16(acc[2] * psc[n2][2] * silu_f(g2), acc[3] * psc[n2][3] * silu_f(g3));
                    *(u32x2*)(MIX + mixf_index(row, col)) = o;
                }
        }
        __syncthreads();
    }
    if ((R0 >> 6) & 1) retention_part<4>(p, R0, w, q4, lr); else retention_part<2>(p, R0, w, q4, lr);
}

__device__ void mini_gemm_task(const Params& p_, int l, int t, LAS unsigned char* lds) {
    const Params p = gp(p_);
    unsigned char* const wsb = ows(p.ws);
    const int tid = otid(), w = __builtin_amdgcn_readfirstlane(tid >> 6), lane = tid & 63, q4 = lane >> 4, lr = lane & 15;
    const int tm = t >> 4, tn = t & 15, mp = w & 1, nh = (w >> 1) & 1, kh = w >> 2;
    constexpr int MGP = 2048 + 64;
    LAS unsigned char* const As = lds + 16384;
    {
        const bf16_t* src = (const bf16_t*)(wsb + WS_MIX) + ((size_t)NP + 64 * tm) * DM;
        u32x4 vv[16];
#pragma unroll
        for (int k = 0; k < 16; ++k) { const int pi = tid + k * NTHREADS; vv[k] = *(const u32x4*)(src + (size_t)(pi >> 7) * DM + (pi & 127) * 8); }
#pragma unroll
        for (int k = 0; k < 16; ++k) { const int pi = tid + k * NTHREADS; *(LAS u32x4*)(As + (pi >> 7) * MGP + (pi & 127) * 16) = vv[k]; }
        __syncthreads();
    }
    const LAS unsigned char* ap0 = As + (32 * mp + lr) * MGP + (512 * kh + 8 * q4) * 2;
    const LAS unsigned char* ap1 = ap0 + 16 * MGP;
    const bf16_t* bp0 = (const bf16_t*)(wsb + WS_WO) + (size_t)l * DM * DM + ((size_t)((tn * 4 + 2 * nh) * 32 + 16 * kh) * 64 + lane) * 8;
    const bf16_t* bp1 = bp0 + 32 * 512;
    f32x4 acc[2][2];
#pragma unroll
    for (int i = 0; i < 2; ++i)
#pragma unroll
        for (int j = 0; j < 2; ++j) acc[i][j] = (f32x4){0.f, 0.f, 0.f, 0.f};
    bf16x8 fa0[2][4], fa1[2][4], fb0[2][4], fb1[2][4];
#define MG_LOAD(s_, kb) do { _Pragma("unroll") for (int k = 0; k < 4; ++k) { fa0[s_][k] = *(const LAS bf16x8*)(ap0 + ((kb) * 4 + k) * 64); fa1[s_][k] = *(const LAS bf16x8*)(ap1 + ((kb) * 4 + k) * 64); \
        fb0[s_][k] = *(const bf16x8*)(bp0 + ((kb) * 4 + k) * 512); fb1[s_][k] = *(const bf16x8*)(bp1 + ((kb) * 4 + k) * 512); } } while (0)
#define MG_MMA(s_) do { _Pragma("unroll") for (int k = 0; k < 4; ++k) { \
        acc[0][0] = __builtin_amdgcn_mfma_f32_16x16x32_bf16(fb0[s_][k], fa0[s_][k], acc[0][0], 0, 0, 0); acc[0][1] = __builtin_amdgcn_mfma_f32_16x16x32_bf16(fb1[s_][k], fa0[s_][k], acc[0][1], 0, 0, 0); \
        acc[1][0] = __builtin_amdgcn_mfma_f32_16x16x32_bf16(fb0[s_][k], fa1[s_][k], acc[1][0], 0, 0, 0); acc[1][1] = __builtin_amdgcn_mfma_f32_16x16x32_bf16(fb1[s_][k], fa1[s_][k], acc[1][1], 0, 0, 0); } } while (0)
    MG_LOAD(0, 0);
#pragma unroll
    for (int kb = 0; kb < 4; kb += 2) {
        MG_LOAD(1, kb + 1);
        __builtin_amdgcn_sched_barrier(0);
        MG_MMA(0);
        __builtin_amdgcn_sched_barrier(0);
        if (kb + 2 < 4) MG_LOAD(0, kb + 2);
        __builtin_amdgcn_sched_barrier(0);
        MG_MMA(1);
        __builtin_amdgcn_sched_barrier(0);
    }
#undef MG_LOAD
#undef MG_MMA
    LAS f32x4* red = (LAS f32x4*)lds;
    if (kh == 1) {
#pragma unroll
        for (int i = 0; i < 2; ++i)
#pragma unroll
            for (int j = 0; j < 2; ++j) red[((w & 3) * 4 + i * 2 + j) * 64 + lane] = acc[i][j];
    }
    __syncthreads();
    if (kh == 0) {
#pragma unroll
        for (int i = 0; i < 2; ++i) {
            float* yp = (float*)(wsb + WS_Y) + ((size_t)NP + 64 * tm + 32 * mp + 16 * i + lr) * DM + 64 * tn + 32 * nh + 4 * q4;
            *(f32x4*)yp = acc[i][0] + red[((w & 3) * 4 + i * 2 + 0) * 64 + lane]; *(f32x4*)(yp + 16) = acc[i][1] + red[((w & 3) * 4 + i * 2 + 1) * 64 + lane];
        }
    }
    __syncthreads();
}

__device__ void inproj_s_task(const Params& p_, int l, int t, LAS unsigned char* lds, bool stage_a) {
    const Params p = gp(p_);
    unsigned char* const wsb = ows(p.ws);
    const int tid = otid(), w = __builtin_amdgcn_readfirstlane(tid >> 6), lane = tid & 63, q4 = lane >> 4, lr = lane & 15;
    const int tm = t / 24, sn = t % 24, jn = w & 3, kh = w >> 2;
    LAS unsigned char* const As = lds + 32768;
    if (stage_a) {
        const bf16_t* src = (const bf16_t*)(wsb + WS_HSF) + (size_t)(2 * tm) * 32 * 512;
        u32x4 vv[8];
#pragma unroll
        for (int k = 0; k < 8; ++k) vv[k] = *(const u32x4*)(src + (size_t)(tid + k * NTHREADS) * 8);
#pragma unroll
        for (int k = 0; k < 8; ++k) *(LAS u32x4*)(As + (tid + k * NTHREADS) * 16) = vv[k];
        __syncthreads();
    }
    const LAS unsigned char* ap0 = As + (16 * kh) * 1024 + lane * 16;
    const LAS unsigned char* ap1 = ap0 + 32 * 1024;
    const bf16_t* bp0 = (const bf16_t*)(wsb + WS_WINF) + (size_t)l * DIN * DM + ((size_t)((sn * 8 + jn) * 32 + 16 * kh) * 64 + lane) * 8;
    const bf16_t* bp1 = bp0 + (size_t)4 * 32 * 512;
    f32x4 acc[2][2];
#pragma unroll
    for (int i = 0; i < 2; ++i)
#pragma unroll
        for (int j = 0; j < 2; ++j) acc[i][j] = (f32x4){0.f, 0.f, 0.f, 0.f};
    bf16x8 fa0[2][4], fa1[2][4], fb0[2][4], fb1[2][4];
#define IS_LOAD(s_, kb) do { _Pragma("unroll") for (int k = 0; k < 4; ++k) { fa0[s_][k] = *(const LAS bf16x8*)(ap0 + ((kb) * 4 + k) * 1024); fa1[s_][k] = *(const LAS bf16x8*)(ap1 + ((kb) * 4 + k) * 1024); \
        fb0[s_][k] = *(const bf16x8*)(bp0 + ((kb) * 4 + k) * 512); fb1[s_][k] = *(const bf16x8*)(bp1 + ((kb) * 4 + k) * 512); } } while (0)
#define IS_MMA(s_) do { _Pragma("unroll") for (int k = 0; k < 4; ++k) { \
        acc[0][0] = __builtin_amdgcn_mfma_f32_16x16x32_bf16(fb0[s_][k], fa0[s_][k], acc[0][0], 0, 0, 0); acc[0][1] = __builtin_amdgcn_mfma_f32_16x16x32_bf16(fb1[s_][k], fa0[s_][k], acc[0][1], 0, 0, 0); \
        acc[1][0] = __builtin_amdgcn_mfma_f32_16x16x32_bf16(fb0[s_][k], fa1[s_][k], acc[1][0], 0, 0, 0); acc[1][1] = __builtin_amdgcn_mfma_f32_16x16x32_bf16(fb1[s_][k], fa1[s_][k], acc[1][1], 0, 0, 0); } } while (0)
    IS_LOAD(0, 0);
#pragma unroll
    for (int kb = 0; kb < 4; kb += 2) {
        IS_LOAD(1, kb + 1);
        __builtin_amdgcn_sched_barrier(0);
        IS_MMA(0);
        __builtin_amdgcn_sched_barrier(0);
        if (kb + 2 < 4) IS_LOAD(0, kb + 2);
        __builtin_amdgcn_sched_barrier(0);
        IS_MMA(1);
        __builtin_amdgcn_sched_barrier(0);
    }
#undef IS_LOAD
#undef IS_MMA
    LAS f32x4* red = (LAS f32x4*)lds;
    if (kh == 1) {
#pragma unroll
        for (int i = 0; i < 2; ++i)
#pragma unroll
            for (int j = 0; j < 2; ++j) red[(jn * 4 + i * 2 + j) * 64 + lane] = acc[i][j];
    }
    __syncthreads();
    if (kh == 0) {
#pragma unroll
        for (int mt = 0; mt < 2; ++mt) {
            const int rs = 32 * tm + 16 * mt + lr, row = NP + rs, colb = 128 * sn, d0 = 16 * jn + 4 * q4;
            f32x4 v0 = acc[mt][0] + red[(jn * 4 + mt * 2 + 0) * 64 + lane], v1 = acc[mt][1] + red[(jn * 4 + mt * 2 + 1) * 64 + lane];
            if (sn >= 4 && sn < 12) {
                const int tpos = 2048 + (rs & 7);
                const f32x4 c4 = *(const f32x4*)((const float*)(wsb + WS_COS) + tpos * 64 + d0), s4 = *(const f32x4*)((const float*)(wsb + WS_SIN) + tpos * 64 + d0);
                f32x4 r0 = v0 * c4 - v1 * s4, r1 = v0 * s4 + v1 * c4;
                if (sn >= 8) { r0 *= 0.08838834764831845f; r1 *= 0.08838834764831845f; }
                v0 = r0; v1 = r1;
            }
            u32x2 w0, w1; w0.x = cvt_pk_bf16(v0[0], v0[1]); w0.y = cvt_pk_bf16(v0[2], v0[3]); w1.x = cvt_pk_bf16(v1[0], v1[1]); w1.y = cvt_pk_bf16(v1[2], v1[3]);
            bf16_t* zp = (bf16_t*)(wsb + WS_ZB) + (size_t)row * DIN + colb + d0;
            *(u32x2*)zp = w0; *(u32x2*)(zp + 64) = w1;
            if (sn < 4) { float* pp = p.out + OUT_POOLS + (size_t)l * SB * 15 * 512 + ((size_t)((rs >> 3) * 15 + 7 + (rs & 7))) * 512 + colb + d0; *(f32x4*)pp = v0; *(f32x4*)(pp + 64) = v1; }
        }
    }
    __syncthreads();
}

__device__ void fusedp_task(const Params& p_, int l, int tile, LAS unsigned char* lds) {
    const Params p = gp(p_);
    unsigned char* const wsb = ows(p.ws);
    const int tid = otid(), w = __builtin_amdgcn_readfirstlane(tid >> 6), lane = tid & 63, q4 = lane >> 4, lr = lane & 15;
    const int R0 = tile * 64, brow = R0 >> 11;
    const bf16_t* MIX = (const bf16_t*)(wsb + WS_MIX); const bf16_t* WoT = (const bf16_t*)(wsb + WS_WO) + (size_t)l * DM * DM;
    const float* mod = (const float*)(wsb + WS_MOD); float* XR = (float*)(wsb + WS_XR); bf16_t* H = (bf16_t*)(wsb + WS_H);
    LAS unsigned char* At = lds;
    {
        const bf16_t* src = MIX + (size_t)(R0 >> 4) * 32 * 512;
        u32x4 v[16];
#pragma unroll
        for (int k = 0; k < 16; ++k) v[k] = __builtin_nontemporal_load((const u32x4*)(src + (size_t)(tid + k * NTHREADS) * 8));
#pragma unroll
        for (int k = 0; k < 16; ++k) *(LAS u32x4*)(At + (tid + k * NTHREADS) * 16) = v[k];
    }
    __syncthreads();
    f32x4 acc[4][8];
#pragma unroll
    for (int mt = 0; mt < 4; ++mt)
#pragma unroll
        for (int nt = 0; nt < 8; ++nt) acc[mt][nt] = (f32x4){0.f, 0.f, 0.f, 0.f};
    const bf16_t* bp = WoT + ((size_t)(w * 8) * 32 * 64 + lane) * 8;
    bf16x8 B0[8], B1[8];
#define FP_LOADB(dst, kk) do { _Pragma("unroll") for (int nt = 0; nt < 8; ++nt) dst[nt] = *(const bf16x8*)(bp + (size_t)(nt * 32 + (kk)) * 512); } while (0)
#define FP_STEP(Bx, kk) do { bf16x8 Af[4]; \
        _Pragma("unroll") for (int mt = 0; mt < 4; ++mt) Af[mt] = *(const LAS bf16x8*)(At + (mt * 32 + (kk)) * 1024 + lane * 16); \
        __builtin_amdgcn_s_setprio(1); \
        _Pragma("unroll") for (int mt = 0; mt < 4; ++mt) _Pragma("unroll") for (int nt = 0; nt < 8; ++nt) acc[mt][nt] = __builtin_amdgcn_mfma_f32_16x16x32_bf16(Bx[nt], Af[mt], acc[mt][nt], 0, 0, 0); \
        __builtin_amdgcn_s_setprio(0); } while (0)
    FP_LOADB(B0, 0);
#pragma unroll 1
    for (int ks = 0; ks < 32; ks += 2) {
        FP_LOADB(B1, ks + 1);
        __builtin_amdgcn_sched_barrier(0);
        FP_STEP(B0, ks);
        __builtin_amdgcn_sched_barrier(0);
        { const int kn = ks + 2 < 32 ? ks + 2 : 31; FP_LOADB(B0, kn); }
        __builtin_amdgcn_sched_barrier(0);
        FP_STEP(B1, ks + 1);
        __builtin_amdgcn_sched_barrier(0);
    }
#undef FP_LOADB
#undef FP_STEP
    constexpr int YP = 4096 + 64;
    const float* xin = (l == 0) ? p.x_prompt : (const float*)XR; float* xo = (l == DEPTH - 1) ? p.out : XR;
    f32x4 gg[4], aa[4], sh[4];
#pragma unroll
    for (int j = 0; j < 4; ++j) { const int col = lane * 4 + j * 256;
        gg[j] = *(const f32x4*)(mod + (size_t)brow * MODLD + l * 3072 + 2048 + col) * *(const f32x4*)(p.g_post + l * DM + col);
        if (l < DEPTH - 1) { aa[j] = *(const f32x4*)(p.g_pre + (l + 1) * DM + col) * (1.0f + *(const f32x4*)(mod + (size_t)brow * MODLD + (l + 1) * 3072 + 1024 + col));
            sh[j] = *(const f32x4*)(mod + (size_t)brow * MODLD + (l + 1) * 3072 + col); }
        else { aa[j] = (f32x4){0.f, 0.f, 0.f, 0.f}; sh[j] = (f32x4){0.f, 0.f, 0.f, 0.f}; } }
#define FP_LOADX(dst, half_, k2_) do { _Pragma("unroll") for (int k = 0; k < 2; ++k) { const size_t off_ = (size_t)(R0 + 32 * (half_) + 4 * w + 2 * (k2_) + k) * DM; \
        _Pragma("unroll") for (int j = 0; j < 4; ++j) dst[k][j] = __builtin_nontemporal_load((const f32x4*)(xin + off_ + lane * 4 + j * 256)); } } while (0)
#define FP_ROWS(xv, half_, k2_) do { _Pragma("unroll") for (int k = 0; k < 2; ++k) { const int rl = 4 * w + 2 * (k2_) + k; const size_t off = (size_t)(R0 + 32 * (half_) + rl) * DM; \
        f32x4 y[4]; float ss = 0.f; \
        _Pragma("unroll") for (int j = 0; j < 4; ++j) { y[j] = *(const LAS f32x4*)(lds + rl * YP + (lane * 4 + j * 256) * 4); ss += y[j][0] * y[j][0] + y[j][1] * y[j][1] + y[j][2] * y[j][2] + y[j][3] * y[j][3]; } \
        ss = wave_sum(ss); const float rsy = rsqrtf(ss * (1.0f / DM) + EPSN); \
        float sx = 0.f; \
        _Pragma("unroll") for (int j = 0; j < 4; ++j) { const f32x4 v = xv[k][j] + gg[j] * (y[j] * rsy); y[j] = v; __builtin_nontemporal_store(v, (f32x4*)(xo + off + lane * 4 + j * 256)); \
            sx += v[0] * v[0] + v[1] * v[1] + v[2] * v[2] + v[3] * v[3]; } \
        if (l < DEPTH - 1) { \
            sx = wave_sum(sx); const float rsx = rsqrtf(sx * (1.0f / DM) + EPSN); \
            _Pragma("unroll") for (int j = 0; j < 4; ++j) { const f32x4 hv = y[j] * rsx * aa[j] + sh[j]; \
                u32x2 o; o.x = cvt_pk_bf16(hv[0], hv[1]); o.y = cvt_pk_bf16(hv[2], hv[3]); \
                __builtin_nontemporal_store(o, (u32x2*)(H + off + lane * 4 + j * 256)); } } } } while (0)
    f32x4 xa[2][4], xb[2][4];
    FP_LOADX(xa, 0, 0);
#pragma unroll
    for (int half = 0; half < 2; ++half) {
        __syncthreads();
#pragma unroll
        for (int m2 = 0; m2 < 2; ++m2)
#pragma unroll
            for (int nt = 0; nt < 8; ++nt) *(LAS f32x4*)(lds + (16 * m2 + lr) * YP + (128 * w + 16 * nt + 4 * q4) * 4) = acc[2 * half + m2][nt];
        __syncthreads();
        FP_LOADX(xb, half, 1);
        __builtin_amdgcn_sched_barrier(0);
        FP_ROWS(xa, half, 0);
        __builtin_amdgcn_sched_barrier(0);
        if (half == 0) FP_LOADX(xa, 1, 0);
        __builtin_amdgcn_sched_barrier(0);
        FP_ROWS(xb, half, 1);
        __builtin_amdgcn_sched_barrier(0);
    }
#undef FP_LOADX
#undef FP_ROWS
    __syncthreads();
}

#define LOADP(q) Params q; { typedef void* const __attribute__((address_space(4)))* kp_t; kp_t kp_ = (kp_t)__builtin_amdgcn_kernarg_segment_ptr(); asm volatile("" : "+s"(kp_)); \
    q.x_prompt = (const float*)kp_[0]; q.x_sample = (const float*)kp_[1]; q.c_prompt = (const float*)kp_[2]; q.c_sample = (const float*)kp_[3]; q.state_ret = (const float*)kp_[4]; q.state_pool = (const float*)kp_[5]; \
    q.w_ada = (const float*)kp_[6]; q.b_ada = (const float*)kp_[7]; q.g_pre = (const float*)kp_[8]; q.g_post = (const float*)kp_[9]; q.w_in = (const float*)kp_[10]; q.w_pool = (const float*)kp_[11]; \
    q.pool_scale = (const float*)kp_[12]; q.w_o = (const float*)kp_[13]; q.out = (float*)kp_[14]; q.ws = (unsigned char*)kp_[15]; }

__global__ void __launch_bounds__(NTHREADS) fwd_megakernel(Params p_arg) {
    extern __shared__ __attribute__((aligned(16))) unsigned char lds_raw[];
    LAS unsigned char* lds = (LAS unsigned char*)lds_raw;
    cg::grid_group grid = cg::this_grid();
    const int G = gridDim.x, bx = blockIdx.x;
    volatile LAS unsigned* bst = (volatile LAS unsigned*)(lds + LDS_USER);
    if (threadIdx.x < 4) bst[threadIdx.x] = 0u;
    __syncthreads();
    const XcdBarrier xbar = xcd_barrier_post((unsigned*)(p_arg.ws + WS_BAR), bst);
#define GSYNC() xcd_barrier(xbar)

    { LOADP(p); phase_prep(p, lds); }
    grid.sync();
    {   LOADP(p);
        pg8::Gemm g{(const bf16_t*)(p.ws + WS_SC), (const bf16_t*)(p.ws + WS_WADA), 256, MODLD, DM};
        pg8::StaticOrder S; S.init(256, MODLD, G, bx);
        pg8::EpiF32 E{(float*)(p.ws + WS_MOD), MODLD, p.b_ada};
        pg8::gemm_phase<pg8::EpiF32, pg8::StaticOrder>(lds, g, S, E);
    }
    GSYNC();
    { LOADP(p); phase_rows(p, -1, 0, 0, NTOK); }
    GSYNC();
#pragma unroll 1
    for (int l = 0; l < DEPTH; ++l) {
        {   LOADP(p);
            pg8::Gemm g{(const bf16_t*)(p.ws + WS_H), (const bf16_t*)(p.ws + WS_WIN) + (size_t)l * DIN * DM, NP, DIN, DM};
            pg8::StaticOrder S; S.init(NP, DIN, G, bx);
            pg8::EpiZ E{p.ws, p.out + OUT_POOLP + (size_t)l * NB * 15 * 512, p.out + OUT_POOLS + (size_t)l * SB * 15 * 512};
            pg8::gemm_phase<pg8::EpiZ, pg8::StaticOrder>(lds, g, S, E);
        }
        { LOADP(p); int prev_tm = -1; for (int t = bx; t < 32 * 24; t += G) { const int r = t >> 8, c = t & 255, x = c & 7, i = c >> 3; inproj_s_task(p, l, i * 24 + x * 3 + r, lds, i != prev_tm); prev_tm = i; } }
        GSYNC();
        { LOADP(p); for (int t = bx; t < 256; t += G) { const int x = t & 7, i = t >> 3; kvscan_task(p, l, (x * 4 + (i >> 3)) * 8 + (i & 7), lds); } }
        { LOADP(p); for (int t = bx; t < 512; t += G) rs_task(p, l, t, lds); }
        GSYNC();
        { LOADP(p); for (int t = bx; t < NP / 64; t += G) { const int x = t & 7, i = t >> 3; mixer_task(p, l, 2 * (x * 16 + (i >> 1)) + (i & 1), lds); } }
        { LOADP(p); for (int t = bx; t < 256; t += G) { const int x = t & 7, i = t >> 3; mini_gemm_task(p, l, (i >> 1) * 16 + 2 * x + (i & 1), lds); } }
        GSYNC();
        { LOADP(p); for (int t = bx; t < NP / 64; t += G) fusedp_task(p, l, t, lds); }
        { LOADP(p); phase_rows(p, l, l + 1, NP, NTOK); }
        GSYNC();
    }
}

extern "C" void kernel_launch(void* const* d_in, const int* in_sizes, int n_in, void* d_out, int out_size, void* d_ws, size_t ws_size, hipStream_t stream) {
    static int grid_blocks = 0;
    if (grid_blocks == 0) {
        if (n_in != 14 || (size_t)out_size != OUT_END || ws_size < WS_END) { fprintf(stderr, "kernel_launch: unexpected shapes (n_in %d out %d ws %zu need %zu)\n", n_in, out_size, ws_size, (size_t)WS_END); grid_blocks = -1; return; }
        int dev = 0, cus = 0, per_cu = 0;
        (void)hipGetDevice(&dev);
        (void)hipDeviceGetAttribute(&cus, hipDeviceAttributeMultiprocessorCount, dev);
        if (hipFuncSetAttribute((const void*)fwd_megakernel, hipFuncAttributeMaxDynamicSharedMemorySize, LDS_BYTES) != hipSuccess) { fprintf(stderr, "kernel_launch: hipFuncSetAttribute failed\n"); grid_blocks = -1; return; }
        if (hipOccupancyMaxActiveBlocksPerMultiprocessor(&per_cu, (const void*)fwd_megakernel, NTHREADS, LDS_BYTES) != hipSuccess || per_cu < 1) { fprintf(stderr, "kernel_launch: occupancy query failed (%d)\n", per_cu); per_cu = 1; (void)hipGetLastError(); }
        grid_blocks = cus;
    }
    if (grid_blocks < 0) return;
    Params p{};
    p.x_prompt = (const float*)d_in[0]; p.x_sample = (const float*)d_in[1]; p.c_prompt = (const float*)d_in[2]; p.c_sample = (const float*)d_in[3];
    p.state_ret = (const float*)d_in[4]; p.state_pool = (const float*)d_in[5]; p.w_ada = (const float*)d_in[6]; p.b_ada = (const float*)d_in[7];
    p.g_pre = (const float*)d_in[8]; p.g_post = (const float*)d_in[9]; p.w_in = (const float*)d_in[10]; p.w_pool = (const float*)d_in[11];
    p.pool_scale = (const float*)d_in[12]; p.w_o = (const float*)d_in[13];
    p.out = (float*)d_out; p.ws = (unsigned char*)d_ws;
    if (hipMemsetAsync((char*)d_ws + WS_BAR, 0, XCD_BAR_WORDS * 4, stream) != hipSuccess) { fprintf(stderr, "kernel_launch: memset failed\n"); return; }
    void* args[] = {&p};
    hipError_t e = hipLaunchCooperativeKernel((const void*)fwd_megakernel, dim3(grid_blocks), dim3(NTHREADS), args, LDS_BYTES, stream);
    if (e != hipSuccess) fprintf(stderr, "cooperative launch failed: %s (grid %d)\n", hipGetErrorString(e), grid_blocks);
}
```

```cpp
#include <hip/hip_runtime.h>
#include <hip/hip_cooperative_groups.h>
#include <cstdio>
#include <cstdint>
namespace cg = cooperative_groups;

#define LAS __attribute__((address_space(3)))
typedef unsigned short bf16_t;
typedef short bf16x8 __attribute__((ext_vector_type(8)));
typedef float f32x4 __attribute__((ext_vector_type(4)));
typedef unsigned u32x4 __attribute__((ext_vector_type(4)));
typedef unsigned u32x2 __attribute__((ext_vector_type(2)));

constexpr int DM = 1024, NP = 16384, NS = 1024, NTOK = NP + NS, DIN = 3072, DEPTH = 4;
constexpr int LP = 2048, NB = 8, SB = 128, SL = 8;
constexpr int MODLD = DEPTH * 3 * DM;
constexpr float EPSN = 1e-6f;

__device__ __forceinline__ bf16_t f2bf(float f) { unsigned u = __float_as_uint(f); u += 0x7FFFu + ((u >> 16) & 1u); return (bf16_t)(u >> 16); }
__device__ __forceinline__ float bf2f(bf16_t b) { return __uint_as_float(((unsigned)b) << 16); }
__device__ __forceinline__ unsigned cvt_pk_bf16(float lo, float hi) { unsigned r; asm volatile("v_cvt_pk_bf16_f32 %0, %1, %2" : "=v"(r) : "v"(lo), "v"(hi)); return r; }
__device__ __forceinline__ float silu_f(float x) { return x * __builtin_amdgcn_rcpf(1.0f + __builtin_amdgcn_exp2f(-1.4426950408889634f * x)); }
__device__ __forceinline__ float fexp2(float x) { return __builtin_amdgcn_exp2f(x); }
__device__ __forceinline__ float lg2gamma(int h) { return log2f(1.0f - exp2f(-5.0f - (float)h)); }
__device__ __forceinline__ float wave_sum(float v) {
#pragma unroll
    for (int o = 32; o >= 1; o >>= 1) v += __shfl_xor(v, o);
    return v;
}

#define GAS __attribute__((address_space(1)))
__device__ __forceinline__ unsigned char* ows(unsigned char* w) { GAS unsigned char* g = (GAS unsigned char*)w; asm volatile("" : "+s"(g)); return (unsigned char*)g; }
template <class T> __device__ __forceinline__ T* as_global(T* q) { GAS T* g = (GAS T*)q; asm volatile("" : "+s"(g)); return (T*)g; }
__device__ __forceinline__ int otid() { int t = (int)threadIdx.x; asm volatile("" : "+v"(t)); return t; }

constexpr size_t al256(size_t x) { return (x + 255) & ~(size_t)255; }
constexpr size_t WS_WIN = 0;
constexpr size_t WS_WO = WS_WIN + al256((size_t)DEPTH * DIN * DM * 2);
constexpr size_t WS_WADA = WS_WO + al256((size_t)DEPTH * DM * DM * 2);
constexpr size_t WS_WPOOL = WS_WADA + al256((size_t)DEPTH * DIN * DM * 2);
constexpr size_t WS_SC = WS_WPOOL + al256((size_t)DEPTH * 4 * 128 * 128 * 2);
constexpr size_t WS_MOD = WS_SC + al256((size_t)256 * DM * 2);
constexpr size_t WS_COS = WS_MOD + al256((size_t)256 * MODLD * 4);
constexpr size_t WS_SIN = WS_COS + al256((size_t)2056 * 64 * 4);
constexpr size_t WS_H = WS_SIN + al256((size_t)2056 * 64 * 4);
constexpr size_t WS_ZB = WS_H + al256((size_t)NTOK * DM * 2);
constexpr size_t WS_KTD = WS_ZB + al256((size_t)NTOK * DIN * 2);
constexpr size_t WS_VT = WS_KTD + al256((size_t)NB * 4 * 128 * LP * 2);
constexpr size_t WS_SPT = WS_VT + al256((size_t)NB * 4 * 128 * LP * 2);
constexpr size_t WS_MIX = WS_SPT + al256((size_t)NB * 16 * 4 * 128 * 128 * 2);
constexpr size_t WS_Y = WS_MIX + al256((size_t)NTOK * DM * 2);
constexpr size_t WS_WINF = WS_Y;
constexpr size_t WS_HSF = WS_Y + ((size_t)32 << 20);
constexpr size_t WS_XR = WS_Y + al256((size_t)NTOK * DM * 4);
constexpr size_t WS_QF = WS_XR + al256((size_t)NTOK * DM * 4);
constexpr size_t WS_KF = WS_QF + al256((size_t)NP * 512 * 2);
constexpr size_t WS_G2 = WS_KF + al256((size_t)NP * 512 * 2);
constexpr size_t WS_BAR = WS_G2 + al256((size_t)NP * DM * 2);
constexpr size_t WS_END = WS_BAR + al256((size_t)3456 * 4);


__device__ __forceinline__ size_t mixf_index(size_t row, int col) { return ((size_t)((row >> 4) * 32 + (col >> 5)) * 64 + (((col >> 3) & 3) * 16 + (row & 15))) * 8 + (col & 7); }
__device__ __forceinline__ size_t g2_index(size_t row, int gc) { return ((size_t)((row >> 4) * 64 + (gc >> 4)) * 64 + (((gc >> 2) & 3) * 16 + (row & 15))) * 4 + (gc & 3); }

__device__ __forceinline__ size_t pf_index(int b, int h, int t, int e) {
    return ((size_t)((((b * 4 + h) * 16 + (t >> 7)) * 4 + ((t >> 5) & 3)) * 128 + e)) * 32 + (((t & 15) >> 2) * 8) + (((t >> 4) & 1) * 4) + (t & 3);
}

namespace pg8 {
constexpr int BM = 256, BK = 64, HALF = 128, HTB = HALF * BK * 2, STAGE_BYTES = 8 * HTB, NXCD = 8, WGM = 8;
__host__ __device__ __forceinline__ int lds_byte(int r, int c) { const int st = (r >> 4) * 2 + (c >> 5), rr = r & 15, cc = c & 31, ob = rr * 64 + cc * 2; return st * 1024 + (ob ^ (((ob >> 9) & 1) << 5)); }
__host__ __device__ __forceinline__ void stage_rc(int b, int& R, int& C) { const int st = b / 1024, sb = b % 1024, swz = sb ^ (((sb >> 9) & 1) << 5); R = (st >> 1) * 16 + swz / 64; C = (st & 1) * 32 + (swz % 64) / 2; }
struct Unit { int pm, pn; };
struct Gemm { const bf16_t* A; const bf16_t* Bt; int M, N, K; };
struct StaticOrder {
    int nM, nN, nwg, G, c;
    __host__ __device__ void init(int M, int N, int G_, int c_) { nM = M / BM; nN = N / BM; nwg = nM * nN; G = G_; c = c_; }
    __host__ __device__ bool next(int i, Unit& u) const {
        const long L = (long)i * G + c; if (L >= nwg) return false;
        int wgid = (int)L; { const int q = nwg / NXCD, r = nwg % NXCD, xcd = wgid % NXCD, off = wgid / NXCD; wgid = (xcd < r ? xcd * (q + 1) : r * (q + 1) + (xcd - r) * q) + off; }
        const int nig = WGM * nN, gid = wgid / nig, fm = gid * WGM, gsz = (nM - fm) < WGM ? (nM - fm) : WGM;
        u.pm = fm + ((wgid % nig) % gsz); u.pn = (wgid % nig) / gsz; return true;
    }
    __device__ __forceinline__ void a_ready(const Unit&) const {}
    __device__ __forceinline__ void done(const Unit&) const {}
};

struct EpiF32 {
    __host__ __device__ static __forceinline__ int bperm(int R) { return R; }
    float* C; int ldc; const float* bias;
    __device__ __forceinline__ void operator()(const f32x4 (&acc)[2][2][4][2], const Unit& u, int wr, int wc, int fr, int fq) const {
        const int row0 = u.pm * BM + wr * 64 + fr, col0 = u.pn * BM + wc * 32 + 4 * fq;
        f32x4 bv[2][2];
#pragma unroll
        for (int bj = 0; bj < 2; ++bj)
#pragma unroll
            for (int n = 0; n < 2; ++n) bv[bj][n] = bias ? *(const f32x4*)(bias + col0 + bj * HALF + n * 16) : (f32x4){0.f, 0.f, 0.f, 0.f};
#pragma unroll
        for (int ai = 0; ai < 2; ++ai)
#pragma unroll
            for (int m = 0; m < 4; ++m) { float* rowp = C + (size_t)(row0 + ai * HALF + m * 16) * ldc + col0;
#pragma unroll
                for (int bj = 0; bj < 2; ++bj)
#pragma unroll
                    for (int n = 0; n < 2; ++n) *(f32x4*)(rowp + bj * HALF + n * 16) = acc[ai][bj][m][n] + bv[bj][n]; }
    }
};

struct EpiZ {
    __host__ __device__ static __forceinline__ int bperm(int R) { return 64 * ((R >> 4) & 1) + 16 * (R >> 5) + (R & 15); }
    unsigned char* ws; float* poolP; float* poolS;
    __device__ __forceinline__ void operator()(const f32x4 (&acc)[2][2][4][2], const Unit& u, int wr, int wc, int fr, int fq) const {
        const int pn = u.pn; const bool prompt = u.pm < 64;
        unsigned char* const wsg = as_global(ws); float* const poolPg = as_global(poolP); float* const poolSg = as_global(poolS);
        bf16_t* const ZB = (bf16_t*)(wsg + WS_ZB); bf16_t* const KTD = (bf16_t*)(wsg + WS_KTD); bf16_t* const VT = (bf16_t*)(wsg + WS_VT); bf16_t* const QF = (bf16_t*)(wsg + WS_QF); bf16_t* const KF = (bf16_t*)(wsg + WS_KF);
        const float* const cosT = (const float*)(wsg + WS_COS); const float* const sinT = (const float*)(wsg + WS_SIN);
        const int d0 = wc * 16 + 4 * fq;
#pragma unroll
        for (int ai = 0; ai < 2; ++ai)
#pragma unroll
            for (int m = 0; m < 4; ++m) {
                const int row = u.pm * BM + ai * HALF + wr * 64 + m * 16 + fr;
                const int tpos = prompt ? (row & 2047) : (2048 + (row & 7));
#pragma unroll
                for (int bj = 0; bj < 2; ++bj) {
                    f32x4 v0 = acc[ai][bj][m][0], v1 = acc[ai][bj][m][1];
                    const int colb = pn * BM + bj * HALF;
                    const int h = (pn & 1) * 2 + bj;
                    if (pn >= 2 && pn < 6) {
                        const f32x4 c4 = *(const f32x4*)(cosT + tpos * 64 + d0), s4 = *(const f32x4*)(sinT + tpos * 64 + d0);
                        f32x4 r0 = v0 * c4 - v1 * s4, r1 = v0 * s4 + v1 * c4;
                        if (pn >= 4) { r0 *= 0.08838834764831845f; r1 *= 0.08838834764831845f; }
                        v0 = r0; v1 = r1;
                    }
                    u32x2 w0, w1; w0.x = cvt_pk_bf16(v0[0], v0[1]); w0.y = cvt_pk_bf16(v0[2], v0[3]); w1.x = cvt_pk_bf16(v1[0], v1[1]); w1.y = cvt_pk_bf16(v1[2], v1[3]);
                    if (prompt && pn >= 2 && pn < 6) {
                        bf16_t* fp = (pn < 4 ? QF : KF) + ((size_t)((((row >> 4) * 4 + h) * 4 + (wc >> 1)) * 64 + (((2 * wc + (fq >> 1)) & 3) * 16 + fr))) * 8 + 4 * (fq & 1);
                        *(u32x2*)fp = w0; *(u32x2*)(fp + 2 * 512) = w1;
                    } else if (prompt && pn >= 8) {
                        bf16_t* gp = (bf16_t*)(wsg + WS_G2) + g2_index((size_t)row, colb - 2048 + d0);
                        *(u32x2*)gp = w0; *(u32x2*)(gp + 4 * 64 * 4) = w1;
                    } else if (!(prompt && pn >= 6 && pn < 8)) {
                        bf16_t* zp = ZB + (size_t)row * DIN + colb + d0;
                        *(u32x2*)zp = w0; *(u32x2*)(zp + 64) = w1;
                    }
                    if (prompt && pn >= 4 && pn < 6) {
                        const int b = row >> 11, t = row & 2047;
                        const float dec = fexp2((float)(127 - (t & 127)) * lg2gamma(h));
                        bf16_t* kp = KTD + pf_index(b, h, t, d0);
#pragma unroll
                        for (int j = 0; j < 4; ++j) { kp[j * 32] = f2bf(v0[j] * dec); kp[(64 + j) * 32] = f2bf(v1[j] * dec); }
                    }
                    if (prompt && pn >= 6 && pn < 8) {
                        const int b = row >> 11, t = row & 2047;
                        bf16_t* vp = VT + pf_index(b, h, t, d0);
#pragma unroll
                        for (int j = 0; j < 4; ++j) { vp[j * 32] = f2bf(v0[j]); vp[(64 + j) * 32] = f2bf(v1[j]); }
                    }
                    if (pn < 2) {
                        if (prompt) { const int b = row >> 11, t = row & 2047;
                            if (t >= 2033) { float* pp = poolPg + ((size_t)(b * 15 + (t - 2033))) * 512 + colb + d0; *(f32x4*)pp = v0; *(f32x4*)(pp + 64) = v1; } }
                        else { const int sb = (row - NP) >> 3, ts = row & 7;
                            float* pp = poolSg + ((size_t)(sb * 15 + 7 + ts)) * 512 + colb + d0; *(f32x4*)pp = v0; *(f32x4*)(pp + 64) = v1; }
                    }
                }
                asm volatile("" ::: "memory");
            }
    }
};

template <class Epi, class Sched>
__device__ __forceinline__ void gemm_phase(LAS unsigned char* lds, const Gemm g, const Sched& S, const Epi& E) {
    const int tid = otid(), wid = __builtin_amdgcn_readfirstlane(tid >> 6), lane = tid & 63, wr = wid >> 2, wc = wid & 3, fr = lane & 15, fq = lane >> 4;
    const int K = g.K, nt = K / BK;
    unsigned voffA[2], voffB[2];
#pragma unroll
    for (int i = 0; i < 2; ++i) { int R, C; stage_rc(tid * 16 + i * 8192, R, C); const int Rb = Epi::bperm(R);
        voffA[i] = (unsigned)(R * K + C) * 2u; voffB[i] = (unsigned)(Rb * K + C) * 2u; }
    const size_t kstep = (size_t)(BK * 2);
    const size_t hstep = (size_t)HALF * K * 2;
    const size_t tstep = 2 * hstep;
    const unsigned ldsw = (unsigned)wid * 1024u;
    const int aoff = lds_byte(wr * 64 + fr, fq * 8), boff = lds_byte(wc * 32 + fr, fq * 8);
#define PG8_SA(b, h) (((b) * 2 + (h)) * HTB)
#define PG8_SB(b, h) ((4 + (b) * 2 + (h)) * HTB)
#define PG8_STAGE(bufoff, gbase, voff) do { _Pragma("unroll") for (int _i = 0; _i < 2; ++_i) \
        __builtin_amdgcn_global_load_lds((const unsigned*)((const char*)(gbase) + (voff)[_i]), (LAS unsigned*)(lds + (bufoff) + ldsw + _i * 8192), 16, 0, 0); } while (0)
#define PG8_LDA(dst, b, h) do { _Pragma("unroll") for (int m = 0; m < 4; ++m) _Pragma("unroll") for (int k = 0; k < 2; ++k) dst[m][k] = *(const LAS bf16x8*)(lds + PG8_SA(b, h) + aoff + m * 2048 + k * 1024); } while (0)
#define PG8_LDB(dst, b, h) do { _Pragma("unroll") for (int n = 0; n < 2; ++n) _Pragma("unroll") for (int k = 0; k < 2; ++k) dst[n][k] = *(const LAS bf16x8*)(lds + PG8_SB(b, h) + boff + n * 2048 + k * 1024); } while (0)
#define PG8_MMA(ai, bj, At, Bt) do { __builtin_amdgcn_s_setprio(1); _Pragma("unroll") for (int m = 0; m < 4; ++m) _Pragma("unroll") for (int n = 0; n < 2; ++n) _Pragma("unroll") for (int k = 0; k < 2; ++k) \
        acc[ai][bj][m][n] = __builtin_amdgcn_mfma_f32_16x16x32_bf16(Bt[n][k], At[m][k], acc[ai][bj][m][n], 0, 0, 0); __builtin_amdgcn_s_setprio(0); } while (0)
#define PG8_WAIT_V(n) asm volatile("s_waitcnt vmcnt(" #n ")" ::: "memory")
#define PG8_WAIT_L(n) asm volatile("s_waitcnt lgkmcnt(" #n ")" ::: "memory")
#define PG8_BAR __builtin_amdgcn_s_barrier()
#define PG8_SCHED __builtin_amdgcn_sched_barrier(0)
    Unit cur, nxt; int ui = 0;
    if (!S.next(0, cur)) return;
    f32x4 acc[2][2][4][2];
#pragma unroll
    for (int a = 0; a < 2; ++a)
#pragma unroll
        for (int b = 0; b < 2; ++b)
#pragma unroll
            for (int m = 0; m < 4; ++m)
#pragma unroll
                for (int n = 0; n < 2; ++n) acc[a][b][m][n] = (f32x4){0.f, 0.f, 0.f, 0.f};
    bf16x8 At[4][2], B0[2][2], B1[2][2];
    const char* cA = (const char*)g.A + (size_t)cur.pm * tstep; const char* cB = (const char*)g.Bt + (size_t)cur.pn * tstep;
    S.a_ready(cur);
    PG8_STAGE(PG8_SB(0, 0), cB, voffB); PG8_STAGE(PG8_SA(0, 0), cA, voffA); PG8_STAGE(PG8_SB(0, 1), cB + hstep, voffB); PG8_STAGE(PG8_SA(0, 1), cA + hstep, voffA);
    if (wr == 1) PG8_BAR;
    PG8_WAIT_V(4); PG8_BAR;
    PG8_STAGE(PG8_SB(1, 0), cB + kstep, voffB); PG8_STAGE(PG8_SA(1, 0), cA + kstep, voffA); PG8_STAGE(PG8_SB(1, 1), cB + hstep + kstep, voffB);
    PG8_WAIT_V(6); PG8_BAR;
    for (;;) {
        const bool has_next = S.next(ui + 1, nxt);
        const char* nA = has_next ? (const char*)g.A + (size_t)nxt.pm * tstep : cA; const char* nB = has_next ? (const char*)g.Bt + (size_t)nxt.pn * tstep : cB;
        for (int t = 0; t < nt; t += 2) {
            const bool last = (t == nt - 2);
            const char* a1 = cA + (size_t)(t + 1) * kstep;
            const char* a2 = last ? nA : cA + (size_t)(t + 2) * kstep; const char* b2 = last ? nB : cB + (size_t)(t + 2) * kstep;
            const char* a3 = a2 + kstep; const char* b3 = b2 + kstep;
            if (last && has_next) S.a_ready(nxt);
            PG8_LDB(B0, 0, 0); PG8_SCHED; PG8_LDA(At, 0, 0); PG8_STAGE(PG8_SA(1, 1), a1 + hstep, voffA);
            PG8_WAIT_L(8); PG8_BAR; PG8_WAIT_L(0); PG8_MMA(0, 0, At, B0); PG8_BAR; PG8_SCHED;
            PG8_LDB(B1, 0, 1); PG8_STAGE(PG8_SB(0, 0), b2, voffB);
            PG8_BAR; PG8_WAIT_L(0); PG8_MMA(0, 1, At, B1); PG8_BAR;
            PG8_LDA(At, 0, 1); PG8_STAGE(PG8_SA(0, 0), a2, voffA);
            PG8_BAR; PG8_WAIT_L(0); PG8_MMA(1, 0, At, B0); PG8_BAR; PG8_SCHED;
            PG8_STAGE(PG8_SB(0, 1), b2 + hstep, voffB);
            PG8_WAIT_V(6); PG8_BAR; PG8_MMA(1, 1, At, B1); PG8_BAR;
            PG8_LDB(B0, 1, 0); PG8_SCHED; PG8_LDA(At, 1, 0); PG8_STAGE(PG8_SA(0, 1), a2 + hstep, voffA);
            PG8_WAIT_L(8); PG8_BAR; PG8_WAIT_L(0); PG8_MMA(0, 0, At, B0); PG8_BAR; PG8_SCHED;
            PG8_LDB(B1, 1, 1); PG8_STAGE(PG8_SB(1, 0), b3, voffB);
            PG8_BAR; PG8_WAIT_L(0); PG8_MMA(0, 1, At, B1); PG8_BAR;
            PG8_LDA(At, 1, 1); PG8_STAGE(PG8_SA(1, 0), a3, voffA);
            PG8_BAR; PG8_WAIT_L(0); PG8_MMA(1, 0, At, B0); PG8_BAR; PG8_SCHED;
            PG8_STAGE(PG8_SB(1, 1), b3 + hstep, voffB);
            PG8_WAIT_V(6); PG8_BAR; PG8_MMA(1, 1, At, B1); PG8_BAR;
        }
        E(acc, cur, wr, wc, fr, fq); S.done(cur);
        if (!has_next) break;
#pragma unroll
        for (int a = 0; a < 2; ++a)
#pragma unroll
            for (int b = 0; b < 2; ++b)
#pragma unroll
                for (int m = 0; m < 4; ++m)
#pragma unroll
                    for (int n = 0; n < 2; ++n) acc[a][b][m][n] = (f32x4){0.f, 0.f, 0.f, 0.f};
        cur = nxt; cA = nA; cB = nB; ++ui;
    }
    PG8_WAIT_V(0);
    if (wr == 0) PG8_BAR;
    PG8_BAR;
#undef PG8_SA
#undef PG8_SB
#undef PG8_STAGE
#undef PG8_LDA
#undef PG8_LDB
#undef PG8_MMA
#undef PG8_WAIT_V
#undef PG8_WAIT_L
#undef PG8_BAR
#undef PG8_SCHED
}
}


#define XB_TMO      128
#define XB_XCNT(j)  (256  + 64 * (j))
#define XB_XSUB(j)  (1280 + 64 * (j))
#define XB_XGEN(j)  (2304 + 64 * (j))
#define XB_TOP      3328
#define XB_TOPGEN   3392
#define XCD_BAR_WORDS 3456
#define XB_SPIN_CAP (1u << 18)
__device__ __forceinline__ unsigned xb_ld(unsigned* p)              { return __hip_atomic_load(p, __ATOMIC_RELAXED, __HIP_MEMORY_SCOPE_AGENT); }
__device__ __forceinline__ unsigned xb_add(unsigned* p, unsigned v) { return __hip_atomic_fetch_add(p, v, __ATOMIC_RELAXED, __HIP_MEMORY_SCOPE_AGENT); }
__device__ __forceinline__ unsigned xb_xcc_id() { return (unsigned)__builtin_amdgcn_s_getreg((3 << 11) | 20) & 0xFu; }
#define XB_SPIN(cond, bar) do { unsigned _sp = 0; while (cond) { __builtin_amdgcn_s_sleep(1); \
    if ((++_sp & 255u) == 0u) { if (xb_ld(&(bar)[XB_TMO])) break; if (_sp > XB_SPIN_CAP) { atomicAdd(&(bar)[XB_TMO], 1u); break; } } } } while (0)
struct XcdBarrier { unsigned* bar; unsigned x; volatile LAS unsigned* st; };
__device__ __forceinline__ XcdBarrier xcd_barrier_post(unsigned* bar, volatile LAS unsigned* st) {
    XcdBarrier b; b.bar = bar; b.x = xb_xcc_id(); b.st = st;
    if (threadIdx.x == 0) (void)xb_add(&bar[XB_XCNT(b.x)], 1u);
    return b;
}
__device__ __forceinline__ void xcd_barrier_complete(unsigned* bar, unsigned x, unsigned& nloc, unsigned& nx) {
    const unsigned G = gridDim.x * gridDim.y * gridDim.z;
    unsigned sum, cnt, mine, sp = 0u;
    for (;;) {
        sum = 0u; cnt = 0u; mine = 0u;
#pragma unroll
        for (unsigned j = 0; j < 16; ++j) { const unsigned c = xb_ld(&bar[XB_XCNT(j)]); sum += c; cnt += (c > 0u) ? 1u : 0u; mine = (j == x) ? c : mine; }
        if (sum == G) break;
        __builtin_amdgcn_s_sleep(1);
        if ((++sp & 255u) == 0u) { if (xb_ld(&bar[XB_TMO])) break; if (sp > XB_SPIN_CAP) { atomicAdd(&bar[XB_TMO], 1u); break; } }
    }
    nloc = mine > 0u ? mine : 1u; nx = cnt > 0u ? cnt : 1u;
}
__device__ __forceinline__ void xcd_barrier(const XcdBarrier& b) {
    asm volatile("s_waitcnt vmcnt(0)" ::: "memory");
    __syncthreads();
    if (threadIdx.x == 0) {
        unsigned* bar = b.bar;
        __builtin_amdgcn_s_waitcnt(0);
        unsigned nloc = b.st[0], nx = b.st[1];
        if (nloc == 0u) { xcd_barrier_complete(bar, b.x, nloc, nx); b.st[0] = nloc; b.st[1] = nx; }
        const unsigned old = xb_add(&bar[XB_XSUB(b.x)], 1u);
        const unsigned gen = old / nloc;
        if (old + 1u == (gen + 1u) * nloc) {
            __builtin_amdgcn_fence(__ATOMIC_RELEASE, "agent");
            asm volatile("s_waitcnt vmcnt(0)" ::: "memory");
            const unsigned og = xb_add(&bar[XB_TOP], 1u);
            const unsigned tg = og / nx;
            if (og + 1u == (tg + 1u) * nx) xb_add(&bar[XB_TOPGEN], 1u);
            else XB_SPIN(xb_ld(&bar[XB_TOPGEN]) == tg, bar);
            __builtin_amdgcn_fence(__ATOMIC_ACQUIRE, "agent");
            xb_add(&bar[XB_XGEN(b.x)], 1u);
            asm volatile("s_waitcnt vmcnt(0)" ::: "memory");
        } else {
            XB_SPIN(xb_ld(&bar[XB_XGEN(b.x)]) == gen, bar);
            __builtin_amdgcn_fence(__ATOMIC_ACQUIRE, "agent");
            asm volatile("s_waitcnt vmcnt(0)" ::: "memory");
        }
    }
    __syncthreads();
}

struct Params {
    const float* x_prompt; const float* x_sample; const float* c_prompt; const float* c_sample;
    const float* state_ret; const float* state_pool; const float* w_ada; const float* b_ada;
    const float* g_pre; const float* g_post; const float* w_in; const float* w_pool; const float* pool_scale; const float* w_o;
    float* out; unsigned char* ws;
};
__device__ __forceinline__ Params gp(const Params& q) { return q; }
constexpr size_t OUT_YP = 0;
constexpr size_t OUT_YS = OUT_YP + (size_t)NP * DM;
constexpr size_t OUT_RETP = OUT_YS + (size_t)NS * DM;
constexpr size_t OUT_POOLP = OUT_RETP + (size_t)DEPTH * NB * 4 * 128 * 128;
constexpr size_t OUT_RETS = OUT_POOLP + (size_t)DEPTH * NB * 15 * 512;
constexpr size_t OUT_POOLS = OUT_RETS + (size_t)DEPTH * SB * 4 * 128 * 128;
constexpr size_t OUT_END = OUT_POOLS + (size_t)DEPTH * SB * 15 * 512;

constexpr int NTHREADS = 512;
constexpr int LDS_USER = 160 * 1024 - 16;
constexpr int LDS_BYTES = 160 * 1024;

struct TcTile { const float* src; bf16_t* dst; int R, C, tr, tc; bool frag; bf16_t* dst2; };
__device__ __forceinline__ TcTile tc_decode(const Params& p_, int t) {
    const Params p = gp(p_);
    unsigned char* const wsb = ows(p.ws);
    bf16_t* WinT = (bf16_t*)(wsb + WS_WIN); bf16_t* WoT = (bf16_t*)(wsb + WS_WO); bf16_t* WadaT = (bf16_t*)(wsb + WS_WADA); bf16_t* WpT = (bf16_t*)(wsb + WS_WPOOL);
    const int T1 = 3072, T2 = 6144, T3 = 7168;
    TcTile x;
    if (t < T1) { const int l = t / 768, r = t % 768; x = TcTile{p.w_in + (size_t)l * DM * DIN, WinT + (size_t)l * DIN * DM, DM, DIN, r / 48, r % 48, false, (bf16_t*)(wsb + WS_WINF) + (size_t)l * DIN * DM}; }
    else if (t < T2) { const int q = t - T1, l = q / 768, r = q % 768; x = TcTile{p.w_ada + (size_t)l * DM * DIN, WadaT + (size_t)l * DIN * DM, DM, DIN, r / 48, r % 48, false, nullptr}; }
    else if (t < T3) { const int q = t - T2, l = q / 256, r = q % 256; x = TcTile{p.w_o + (size_t)l * DM * DM, WoT + (size_t)l * DM * DM, DM, DM, r / 16, r % 16, true, nullptr}; }
    else { const int q = t - T3, m = q / 4, r = q % 4; x = TcTile{p.w_pool + (size_t)m * 128 * 128, WpT + (size_t)m * 128 * 128, 128, 128, r / 2, r % 2, false, nullptr}; }
    return x;
}

__device__ void phase_prep(const Params& p_, LAS unsigned char* lds) {
    const Params p = gp(p_);
    unsigned char* const wsb = ows(p.ws);
    LAS float* tile = (LAS float*)lds;
    const int tid = otid();
    const int T4 = 7232;
    for (int t0 = blockIdx.x * 4; t0 < T4; t0 += gridDim.x * 4) {
        f32x4 va[4], vb[4];
        const int r = tid >> 3, c0 = (tid & 7) * 8;
#pragma unroll
        for (int q = 0; q < 4; ++q) { const TcTile x = tc_decode(p, t0 + q);
            const float* sp = x.src + (size_t)(x.tr * 64 + r) * x.C + x.tc * 64 + c0;
            va[q] = __builtin_nontemporal_load((const f32x4*)sp); vb[q] = __builtin_nontemporal_load((const f32x4*)(sp + 4)); }
#pragma unroll
        for (int q = 0; q < 4; ++q) { LAS float* tl = tile + q * 64 * 65;
#pragma unroll
            for (int k = 0; k < 4; ++k) { tl[(c0 + k) * 65 + r] = va[q][k]; tl[(c0 + 4 + k) * 65 + r] = vb[q][k]; } }
        __syncthreads();
#pragma unroll
        for (int q = 0; q < 4; ++q) { const TcTile x = tc_decode(p, t0 + q); LAS float* tl = tile + q * 64 * 65;
            const int cc = tid >> 3, r8 = (tid & 7) * 8;
            u32x4 wv;
            wv.x = cvt_pk_bf16(tl[cc * 65 + r8 + 0], tl[cc * 65 + r8 + 1]); wv.y = cvt_pk_bf16(tl[cc * 65 + r8 + 2], tl[cc * 65 + r8 + 3]);
            wv.z = cvt_pk_bf16(tl[cc * 65 + r8 + 4], tl[cc * 65 + r8 + 5]); wv.w = cvt_pk_bf16(tl[cc * 65 + r8 + 6], tl[cc * 65 + r8 + 7]);
            const int n = x.tc * 64 + cc, k = x.tr * 64 + r8;
            const size_t di = x.frag ? ((size_t)(((n >> 4) * 32 + (k >> 5)) * 64 + (((k >> 3) & 3) * 16 + (n & 15)))) * 8 : (size_t)n * x.R + k;
            *(u32x4*)(x.dst + di) = wv;
            if (x.dst2) *(u32x4*)(x.dst2 + ((size_t)(((n >> 4) * 32 + (k >> 5)) * 64 + (((k >> 3) & 3) * 16 + (n & 15)))) * 8) = wv; }
        __syncthreads();
    }
    const int gtid = blockIdx.x * NTHREADS + otid(), gn = gridDim.x * NTHREADS;
    bf16_t* SC = (bf16_t*)(wsb + WS_SC);
    for (int i = gtid; i < 256 * DM; i += gn) { const int r = i >> 10, k = i & 1023;
        float v = 0.f; if (r < NB) v = silu_f(p.c_prompt[r * DM + k]); else if (r < NB + SB) v = silu_f(p.c_sample[(r - NB) * DM + k]);
        SC[i] = f2bf(v); }
    float* cosT = (float*)(wsb + WS_COS); float* sinT = (float*)(wsb + WS_SIN);
    for (int i = gtid; i < 2056 * 64; i += gn) { const int tp = i >> 6, f = i & 63;
        const float pos = (float)(tp < 2048 ? tp : (16384 + tp - 2048));
        const float inv = 1.0f / powf(10000.0f, (float)f * (1.0f / 64.0f));
        const float ang = pos * inv;
        const double a = (double)ang; const double kq = rint(a * 0.63661977236758134308); const double r = a - kq * 1.57079632679489661923;
        const double r2 = r * r;
        const double sn = r * (1.0 + r2 * (-1.0 / 6 + r2 * (1.0 / 120 + r2 * (-1.0 / 5040 + r2 * (1.0 / 362880 + r2 * (-1.0 / 39916800))))));
        const double cs = 1.0 + r2 * (-0.5 + r2 * (1.0 / 24 + r2 * (-1.0 / 720 + r2 * (1.0 / 40320 + r2 * (-1.0 / 3628800 + r2 * (1.0 / 479001600))))));
        const int qd = ((int)(long long)kq) & 3;
        double c, s; if (qd == 0) { c = cs; s = sn; } else if (qd == 1) { c = -sn; s = cs; } else if (qd == 2) { c = -cs; s = -sn; } else { c = sn; s = -cs; }
        cosT[i] = (float)c; sinT[i] = (float)s; }
}

__device__ void phase_rows(const Params& p_, int l_prev, int l_next, int row_lo, int row_hi) {
    const Params p = gp(p_);
    unsigned char* const wsb = ows(p.ws);
    const int tid0 = otid(); const int wave = tid0 >> 6, lane = tid0 & 63;
    const float* mod = (const float*)(wsb + WS_MOD); const float* Y = (const float*)(wsb + WS_Y);
    float* XR = (float*)(wsb + WS_XR); bf16_t* H = (bf16_t*)(wsb + WS_H);
    for (int row = row_lo + blockIdx.x * 8 + wave; row < row_hi; row += gridDim.x * 8) {
        const int brow = row < NP ? (row >> 11) : (NB + ((row - NP) >> 3));
        const float* xin = (l_prev <= 0) ? (row < NP ? p.x_prompt + (size_t)row * DM : p.x_sample + (size_t)(row - NP) * DM) : XR + (size_t)row * DM;
        f32x4 x[4];
#pragma unroll
        for (int j = 0; j < 4; ++j) x[j] = __builtin_nontemporal_load((const f32x4*)(xin + lane * 4 + j * 256));
        if (l_prev >= 0) {
            f32x4 y[4]; float ss = 0.f;
#pragma unroll
            for (int j = 0; j < 4; ++j) { y[j] = __builtin_nontemporal_load((const f32x4*)(Y + (size_t)row * DM + lane * 4 + j * 256)); ss += y[j][0] * y[j][0] + y[j][1] * y[j][1] + y[j][2] * y[j][2] + y[j][3] * y[j][3]; }
            ss = wave_sum(ss); const float rstd = rsqrtf(ss * (1.0f / DM) + EPSN);
            float* xo = (l_prev == DEPTH - 1) ? p.out + (size_t)row * DM : XR + (size_t)row * DM;
#pragma unroll
            for (int j = 0; j < 4; ++j) { const int col = lane * 4 + j * 256;
                const f32x4 gr = *(const f32x4*)(mod + (size_t)brow * MODLD + l_prev * 3072 + 2048 + col), gp = *(const f32x4*)(p.g_post + l_prev * DM + col);
                x[j] = x[j] + gr * (y[j] * rstd * gp); *(f32x4*)(xo + col) = x[j]; }
        }
        if (l_next < DEPTH) {
            float ss = 0.f;
#pragma unroll
            for (int j = 0; j < 4; ++j) ss += x[j][0] * x[j][0] + x[j][1] * x[j][1] + x[j][2] * x[j][2] + x[j][3] * x[j][3];
            ss = wave_sum(ss); const float rstd = rsqrtf(ss * (1.0f / DM) + EPSN);
#pragma unroll
            for (int j = 0; j < 4; ++j) { const int col = lane * 4 + j * 256;
                const f32x4 sh = *(const f32x4*)(mod + (size_t)brow * MODLD + l_next * 3072 + col), sc = *(const f32x4*)(mod + (size_t)brow * MODLD + l_next * 3072 + 1024 + col), gp = *(const f32x4*)(p.g_pre + l_next * DM + col);
                const f32x4 hv = x[j] * rstd * gp * (1.0f + sc) + sh;
                u32x2 w; w.x = cvt_pk_bf16(hv[0], hv[1]); w.y = cvt_pk_bf16(hv[2], hv[3]);
                if (row < NP) *(u32x2*)(H + (size_t)row * DM + col) = w;
                else *(u32x2*)((bf16_t*)(wsb + WS_HSF) + mixf_index((size_t)(row - NP), col)) = w; }
        }
    }
}

__device__ void kvscan_task(const Params& p_, int l, int task, LAS unsigned char* lds) {
    const Params p = gp(p_);
    unsigned char* const wsb = ows(p.ws);
    const int tid0 = otid(); const int wave = __builtin_amdgcn_readfirstlane(tid0 >> 6), lane = tid0 & 63, q4 = lane >> 4, lr = lane & 15;
    const int bh = task >> 3, es = task & 7, h = bh & 3, b = bh >> 2;
    const bf16_t* KTD = (const bf16_t*)(wsb + WS_KTD); const bf16_t* VT = (const bf16_t*)(wsb + WS_VT); bf16_t* SPT = (bf16_t*)(wsb + WS_SPT);
    const bf16_t* ka = KTD + (size_t)bh * 16 * 4 * 128 * 32 + (16 * wave + lr) * 32 + 8 * q4;
    const float g128 = fexp2(128.0f * lg2gamma(h));
    f32x4 S = {0.f, 0.f, 0.f, 0.f};
    const int e = 16 * es + lr, d0 = 16 * wave + 4 * q4;
    {
        u32x4 vv[8];
#pragma unroll
        for (int k = 0; k < 8; ++k) { const int pi = tid0 + k * NTHREADS; vv[k] = *(const u32x4*)(VT + (size_t)bh * 16 * 4 * 128 * 32 + (size_t)(pi >> 6) * 4096 + es * 512 + (pi & 63) * 8); }
#pragma unroll
        for (int k = 0; k < 8; ++k) { const int pi = tid0 + k * NTHREADS; *(LAS u32x4*)(lds + pi * 16) = vv[k]; }
        __syncthreads();
    }
    bf16x8 fa[2][4], fb[2][4];
#define KV_LOAD(s_, n_) do { _Pragma("unroll") for (int ks = 0; ks < 4; ++ks) { fa[s_][ks] = *(const bf16x8*)(ka + ((n_) * 4 + ks) * 4096); fb[s_][ks] = *(const LAS bf16x8*)(lds + ((n_) * 4 + ks) * 1024 + (lr * 4 + q4) * 16); } } while (0)
#define KV_STEP(s_, n_) do { f32x4 kv = {0.f, 0.f, 0.f, 0.f}; \
        _Pragma("unroll") for (int ks = 0; ks < 4; ++ks) kv = __builtin_amdgcn_mfma_f32_16x16x32_bf16(fa[s_][ks], fb[s_][ks], kv, 0, 0, 0); \
        u32x2 wv; wv.x = cvt_pk_bf16(S[0], S[1]); wv.y = cvt_pk_bf16(S[2], S[3]); \
        *(u32x2*)(SPT + ((size_t)((((((b * 16 + (n_)) * 4 + h) * 8 + es) * 4 + (wave >> 1)) * 64) + (((2 * wave + (q4 >> 1)) & 3) * 16 + lr))) * 8 + 4 * (q4 & 1)) = wv; \
        S = S * g128 + kv; } while (0)
    KV_LOAD(0, 0);
#pragma unroll
    for (int n = 0; n < 16; n += 2) {
        KV_LOAD(1, n + 1);
        __builtin_amdgcn_sched_barrier(0);
        KV_STEP(0, n);
        __builtin_amdgcn_sched_barrier(0);
        if (n + 2 < 16) KV_LOAD(0, n + 2);
        __builtin_amdgcn_sched_barrier(0);
        KV_STEP(1, n + 1);
        __builtin_amdgcn_sched_barrier(0);
    }
#undef KV_LOAD
#undef KV_STEP
    float* rp = p.out + OUT_RETP + ((size_t)((l * NB + b) * 4 + h)) * 16384;
#pragma unroll
    for (int r = 0; r < 4; ++r) rp[(d0 + r) * 128 + e] = S[r];
    __syncthreads();
}

__device__ void rs_task(const Params& p_, int l, int task, LAS unsigned char* lds) {
    const Params p = gp(p_);
    unsigned char* const wsb = ows(p.ws);
    const int tid = otid(), w = __builtin_amdgcn_readfirstlane(tid >> 6), lane = tid & 63, q4 = lane >> 4, lr = lane & 15, b = task >> 2, h = task & 3;
    const bf16_t* ZB = (const bf16_t*)(wsb + WS_ZB); bf16_t* MIX = (bf16_t*)(wsb + WS_MIX);
    LAS float* qT = (LAS float*)lds;
    LAS float* kT = qT + 1024;
    LAS float* kdT = kT + 1024;
    LAS float* vS = kdT + 1024;
    LAS float* sc = vS + 1024;
    LAS float* red = sc + 64;
    LAS float* uF = red + 16 * 8 * 128;
    LAS float* mS = uF + 23 * 128;
    const float lg = lg2gamma(h);
    const size_t r0 = (size_t)NP + b * 8;
    const int g = h, win = 2 << g;
    const float* S0 = p.state_ret + ((size_t)((l * SB + b) * 4 + h)) * 16384;
    float* S1 = p.out + OUT_RETS + ((size_t)((l * SB + b) * 4 + h)) * 16384;
    const int e4 = (tid & 31) * 4, dg = tid >> 5;
    f32x4 s0[8];
#pragma unroll
    for (int dd = 0; dd < 8; ++dd) s0[dd] = __builtin_nontemporal_load((const f32x4*)(S0 + (dg * 8 + dd) * 128 + e4));
    const int li = tid >> 6, ld2 = (tid & 63) * 2;
    const unsigned qv = __builtin_nontemporal_load((const unsigned*)(ZB + (r0 + li) * DIN + 512 + h * 128 + ld2)), kv = __builtin_nontemporal_load((const unsigned*)(ZB + (r0 + li) * DIN + 1024 + h * 128 + ld2)), vv = __builtin_nontemporal_load((const unsigned*)(ZB + (r0 + li) * DIN + 1536 + h * 128 + ld2));
    f32x4 hist = {0.f, 0.f, 0.f, 0.f}; u32x2 ucur = {0u, 0u};
    if (tid < 480) hist = __builtin_nontemporal_load((const f32x4*)(p.state_pool + ((size_t)(l * SB + b) * 15 + (tid >> 5)) * 512 + g * 128 + (tid & 31) * 4));
    if (tid < 256) ucur = *(const u32x2*)(ZB + (r0 + (tid >> 5)) * DIN + g * 128 + (tid & 31) * 4);
    const bf16_t gr0 = ZB[(r0 + li) * DIN + 2560 + h * 128 + lane], gr1 = ZB[(r0 + li) * DIN + 2560 + h * 128 + lane + 64];
    const bf16_t* WpT = (const bf16_t*)(wsb + WS_WPOOL) + (size_t)(l * 4 + g) * 16384;
    bf16x8 wf[4];
#pragma unroll
    for (int ks = 0; ks < 4; ++ks) wf[ks] = *(const bf16x8*)(WpT + (size_t)(16 * w + lr) * 128 + ks * 32 + 8 * q4);
    const int pcol = g * 128 + 16 * w + 4 * q4;
    const f32x4 psc = *(const f32x4*)(p.pool_scale + l * 512 + pcol);
    u32x2 gpq = {0u, 0u}; if (lr < 8) gpq = *(const u32x2*)(ZB + (r0 + lr) * DIN + 2048 + pcol);
    float cp[7];
    if (h == 0) {
#pragma unroll
        for (int k = 0; k < 7; ++k) cp[k] = p.state_pool[((size_t)(l * SB + b) * 15 + 8) * 512 + tid + k * NTHREADS];
    }
    __builtin_amdgcn_sched_barrier(0);
    { const float kd = fexp2((float)(7 - li) * lg);
      qT[ld2 * 8 + li] = __uint_as_float(qv << 16); qT[(ld2 + 1) * 8 + li] = __uint_as_float(qv & 0xffff0000u);
      const float k0 = __uint_as_float(kv << 16), k1 = __uint_as_float(kv & 0xffff0000u);
      kT[ld2 * 8 + li] = k0; kT[(ld2 + 1) * 8 + li] = k1; kdT[ld2 * 8 + li] = k0 * kd; kdT[(ld2 + 1) * 8 + li] = k1 * kd;
      vS[li * 128 + ld2] = __uint_as_float(vv << 16); vS[li * 128 + ld2 + 1] = __uint_as_float(vv & 0xffff0000u);
      if (tid < 480) *(LAS f32x4*)(uF + (tid >> 5) * 128 + (tid & 31) * 4) = hist;
      if (tid < 256) *(LAS f32x4*)(uF + (15 + (tid >> 5)) * 128 + (tid & 31) * 4) = (f32x4){__uint_as_float(ucur.x << 16), __uint_as_float(ucur.x & 0xffff0000u), __uint_as_float(ucur.y << 16), __uint_as_float(ucur.y & 0xffff0000u)};
      mS[1024 + tid] = 0.f; mS[1536 + tid] = 0.f; }
    __syncthreads();
    {
      const int pr = tid >> 3, i = pr >> 3, j = pr & 7, dp = tid & 7; float sv = 0.f;
#pragma unroll
      for (int d = dp * 16; d < dp * 16 + 16; ++d) sv += qT[d * 8 + i] * kT[d * 8 + j];
      sv += __shfl_xor(sv, 1); sv += __shfl_xor(sv, 2); sv += __shfl_xor(sv, 4);
      if (dp == 0) sc[pr] = (j <= i) ? sv * fexp2((float)(i - j) * lg) : 0.f; }
    {
      const int c = tid & 127, tq = tid >> 7; const float rw = 1.0f / (float)win;
#pragma unroll
      for (int k2 = 0; k2 < 2; ++k2) { const int ts = 2 * tq + k2; float sm = 0.f;
          for (int k = 0; k < win; ++k) sm += uF[(15 + ts - k) * 128 + c];
          mS[ts * 128 + c] = sm * rw - uF[(15 + ts) * 128 + c]; } }
    {
        const float g8 = fexp2(8.0f * lg);
        f32x4 cr[8], vj[8];
#pragma unroll
        for (int i = 0; i < 8; ++i) { cr[i] = (f32x4){0.f, 0.f, 0.f, 0.f}; vj[i] = *(const LAS f32x4*)(vS + i * 128 + e4); }
#pragma unroll
        for (int dd = 0; dd < 8; ++dd) { const int d = dg * 8 + dd;
            const f32x4 qa = *(const LAS f32x4*)(qT + d * 8), qb = *(const LAS f32x4*)(qT + d * 8 + 4), ka = *(const LAS f32x4*)(kdT + d * 8), kb = *(const LAS f32x4*)(kdT + d * 8 + 4);
            f32x4 sf = s0[dd] * g8;
#pragma unroll
            for (int i = 0; i < 4; ++i) { cr[i] += s0[dd] * qa[i]; cr[4 + i] += s0[dd] * qb[i]; sf += vj[i] * ka[i]; sf += vj[4 + i] * kb[i]; }
            __builtin_nontemporal_store(sf, (f32x4*)(S1 + d * 128 + e4)); }
#pragma unroll
        for (int i = 0; i < 8; ++i) *(LAS f32x4*)(red + (dg * 8 + i) * 128 + e4) = cr[i];
    }
    __syncthreads();
    { const int i = li; float o[2]; float ss = 0.f;
#pragma unroll
      for (int k = 0; k < 2; ++k) { const int e = lane + 64 * k;
          float cross = 0.f;
#pragma unroll
          for (int d2 = 0; d2 < 16; ++d2) cross += red[(d2 * 8 + i) * 128 + e];
          float v = fexp2((float)(i + 1) * lg) * cross;
#pragma unroll
          for (int j = 0; j < 8; ++j) v += sc[i * 8 + j] * vS[j * 128 + e];
          o[k] = v; ss += v * v; }
      ss = wave_sum(ss); const float rstd = rsqrtf(ss * (1.0f / 128.0f) + EPSN);
      MIX[(r0 + i) * DM + 512 + h * 128 + lane] = f2bf(o[0] * rstd * silu_f(bf2f(gr0)));
      MIX[(r0 + i) * DM + 512 + h * 128 + lane + 64] = f2bf(o[1] * rstd * silu_f(bf2f(gr1))); }
    {
        f32x4 acc = {0.f, 0.f, 0.f, 0.f};
#pragma unroll
        for (int ks = 0; ks < 4; ++ks) { const f32x4 m0 = *(const LAS f32x4*)(mS + lr * 128 + ks * 32 + 8 * q4), m1 = *(const LAS f32x4*)(mS + lr * 128 + ks * 32 + 8 * q4 + 4);
            const bf16x8 mf = __builtin_bit_cast(bf16x8, (u32x4){cvt_pk_bf16(m0[0], m0[1]), cvt_pk_bf16(m0[2], m0[3]), cvt_pk_bf16(m1[0], m1[1]), cvt_pk_bf16(m1[2], m1[3])});
            acc = __builtin_amdgcn_mfma_f32_16x16x32_bf16(wf[ks], mf, acc, 0, 0, 0); }
        if (lr < 8) { const float g0 = __uint_as_float(gpq.x << 16), g1 = __uint_as_float(gpq.x & 0xffff0000u), g2 = __uint_as_float(gpq.y << 16), g3 = __uint_as_float(gpq.y & 0xffff0000u);
            u32x2 o; o.x = cvt_pk_bf16(acc[0] * psc[0] * silu_f(g0), acc[1] * psc[1] * silu_f(g1)); o.y = cvt_pk_bf16(acc[2] * psc[2] * silu_f(g2), acc[3] * psc[3] * silu_f(g3));
            *(u32x2*)(MIX + (r0 + lr) * DM + pcol) = o; }
    }
    if (h == 0) {
        float* dp = p.out + OUT_POOLS + ((size_t)(l * SB + b) * 15) * 512;
#pragma unroll
        for (int k = 0; k < 7; ++k) dp[tid + k * NTHREADS] = cp[k];
    }
    __syncthreads();
}

template <int NPAIR>
__device__ __forceinline__ void retention_part(const Params& p_, int R0, int w, int q4, int lr) {
    const Params p = gp(p_);
    unsigned char* const wsb = ows(p.ws);
    const int lane = q4 * 16 + lr;
    const bf16_t* QF = (const bf16_t*)(wsb + WS_QF); const bf16_t* KF = (const bf16_t*)(wsb + WS_KF);
    const bf16_t* G2 = (const bf16_t*)(wsb + WS_G2); bf16_t* MIX = (bf16_t*)(wsb + WS_MIX);
    const bf16_t* VT = (const bf16_t*)(wsb + WS_VT); const bf16_t* SPT = (const bf16_t*)(wsb + WS_SPT);
    const int h = w >> 1, itb = 2 * (w & 1), b = R0 >> 11, n = (R0 & 2047) >> 7, itg0 = 4 * (NPAIR / 2 - 1) + itb;
    const size_t t0 = (size_t)(R0 & ~127);
    const float lg = lg2gamma(h);
    bf16x8 qf[2][4];
#pragma unroll
    for (int i2 = 0; i2 < 2; ++i2) { const bf16_t* qp = QF + ((size_t)((((R0 >> 4) + itb + i2) * 4 + h) * 4) * 64 + lane) * 8;
#pragma unroll
        for (int ks = 0; ks < 4; ++ks) qf[i2][ks] = __builtin_nontemporal_load((const bf16x8*)(qp + ks * 512)); }
    f32x4 acc[2][8];
#pragma unroll
    for (int i2 = 0; i2 < 2; ++i2)
#pragma unroll
        for (int et = 0; et < 8; ++et) acc[i2][et] = (f32x4){0.f, 0.f, 0.f, 0.f};
#pragma unroll
    for (int eq = 0; eq < 4; ++eq) {
        bf16x8 sf[2][4];
#pragma unroll
        for (int e2 = 0; e2 < 2; ++e2) { const bf16_t* sp = SPT + ((size_t)(((((b * 16 + n) * 4 + h) * 8 + eq * 2 + e2) * 4) * 64) + lane) * 8;
#pragma unroll
            for (int ks = 0; ks < 4; ++ks) sf[e2][ks] = *(const bf16x8*)(sp + ks * 512); }
        __builtin_amdgcn_sched_barrier(0);
#pragma unroll
        for (int e2 = 0; e2 < 2; ++e2)
#pragma unroll
            for (int ks = 0; ks < 4; ++ks) {
                acc[0][eq * 2 + e2] = __builtin_amdgcn_mfma_f32_16x16x32_bf16(sf[e2][ks], qf[0][ks], acc[0][eq * 2 + e2], 0, 0, 0);
                acc[1][eq * 2 + e2] = __builtin_amdgcn_mfma_f32_16x16x32_bf16(sf[e2][ks], qf[1][ks], acc[1][eq * 2 + e2], 0, 0, 0); }
    }
#pragma unroll
    for (int i2 = 0; i2 < 2; ++i2) { const float dec = fexp2((float)(16 * (itg0 + i2) + lr + 1) * lg);
#pragma unroll
        for (int et = 0; et < 8; ++et) acc[i2][et] *= dec; }
#pragma unroll
    for (int jp = 0; jp < NPAIR; ++jp) {
        if (2 * jp <= itg0 + 1) {
            bf16x8 kf[2][4], vf[8];
#pragma unroll
            for (int hf = 0; hf < 2; ++hf) { const bf16_t* kp = KF + ((size_t)((((t0 >> 4) + 2 * jp + hf) * 4 + h) * 4) * 64 + lane) * 8;
#pragma unroll
                for (int ks = 0; ks < 4; ++ks) kf[hf][ks] = *(const bf16x8*)(kp + ks * 512); }
#pragma unroll
            for (int et = 0; et < 8; ++et) vf[et] = *(const bf16x8*)(VT + ((size_t)((((b * 4 + h) * 16 + n) * 4 + jp) * 128 + 16 * et + lr)) * 32 + 8 * q4);
            __builtin_amdgcn_sched_barrier(0);
#pragma unroll
            for (int i2 = 0; i2 < 2; ++i2) {
                const int itg = itg0 + i2;
                if (2 * jp <= itg) {
                    unsigned pw[4];
#pragma unroll
                    for (int hf = 0; hf < 2; ++hf) {
                        f32x4 sacc = {0.f, 0.f, 0.f, 0.f};
#pragma unroll
                        for (int ks = 0; ks < 4; ++ks) sacc = __builtin_amdgcn_mfma_f32_16x16x32_bf16(kf[hf][ks], qf[i2][ks], sacc, 0, 0, 0);
                        float pv[4];
#pragma unroll
                        for (int r = 0; r < 4; ++r) { const int diff = (16 * itg + lr) - (16 * (2 * jp + hf) + 4 * q4 + r); pv[r] = (diff >= 0) ? sacc[r] * fexp2((float)diff * lg) : 0.f; }
                        pw[2 * hf] = cvt_pk_bf16(pv[0], pv[1]); pw[2 * hf + 1] = cvt_pk_bf16(pv[2], pv[3]);
                    }
                    const bf16x8 P = __builtin_bit_cast(bf16x8, (u32x4){pw[0], pw[1], pw[2], pw[3]});
#pragma unroll
                    for (int et = 0; et < 8; ++et) acc[i2][et] = __builtin_amdgcn_mfma_f32_16x16x32_bf16(vf[et], P, acc[i2][et], 0, 0, 0);
                }
            }
        }
    }
#pragma unroll
    for (int i2 = 0; i2 < 2; ++i2) {
        const size_t row = (size_t)R0 + 16 * (itb + i2) + lr;
        u32x2 gqv[8];
#pragma unroll
        for (int et = 0; et < 8; ++et) gqv[et] = __builtin_nontemporal_load((const u32x2*)(G2 + g2_index(row, 512 + h * 128 + 16 * et + 4 * q4)));
        float ss = 0.f;
#pragma unroll
        for (int et = 0; et < 8; ++et)
#pragma unroll
            for (int r = 0; r < 4; ++r) ss += acc[i2][et][r] * acc[i2][et][r];
        ss += __shfl_xor(ss, 16); ss += __shfl_xor(ss, 32);
        const float rstd = rsqrtf(ss * (1.0f / 128.0f) + EPSN);
#pragma unroll
        for (int et = 0; et < 8; ++et) { const int col = 512 + h * 128 + 16 * et + 4 * q4;
            const u32x2 gg = gqv[et];
            const float g0 = __uint_as_float(gg.x << 16), g1 = __uint_as_float(gg.x & 0xffff0000u), g2 = __uint_as_float(gg.y << 16), g3 = __uint_as_float(gg.y & 0xffff0000u);
            u32x2 o; o.x = cvt_pk_bf16(acc[i2][et][0] * rstd * silu_f(g0), acc[i2][et][1] * rstd * silu_f(g1)); o.y = cvt_pk_bf16(acc[i2][et][2] * rstd * silu_f(g2), acc[i2][et][3] * rstd * silu_f(g3));
            *(u32x2*)(MIX + mixf_index(row, col)) = o; }
    }
}

__device__ void mixer_task(const Params& p_, int l, int tile, LAS unsigned char* lds) {
    const Params p = gp(p_);
    unsigned char* const wsb = ows(p.ws);
    const int tid = otid(), w = __builtin_amdgcn_readfirstlane(tid >> 6), lane = tid & 63, q4 = lane >> 4, lr = lane & 15;
    const int R0 = tile * 64;
    const bf16_t* ZB = (const bf16_t*)(wsb + WS_ZB); bf16_t* MIX = (bf16_t*)(wsb + WS_MIX);
    LAS bf16_t* U = (LAS bf16_t*)lds;
    LAS bf16_t* Mm = (LAS bf16_t*)(lds + 80896);
    {
        const int tl0 = R0 & 2047;
        u32x4 v[10];
#pragma unroll
        for (int k = 0; k < 10; ++k) { const int idx = tid + k * NTHREADS, rr = idx >> 6, c8 = (idx & 63) * 8;
            v[k] = (u32x4){0u, 0u, 0u, 0u};
            if (idx < 79 * 64 && tl0 - 15 + rr >= 0) v[k] = __builtin_nontemporal_load((const u32x4*)(ZB + (size_t)(R0 - 15 + rr) * DIN + c8)); }
#pragma unroll
        for (int k = 0; k < 10; ++k) { const int idx = tid + k * NTHREADS, rr = idx >> 6, c8 = (idx & 63) * 8;
            if (idx < 79 * 64) *(LAS u32x4*)(U + rr * 512 + c8) = v[k]; }
        __syncthreads();
        const int c = tid, win = 2 << (c >> 7);
        float s = 0.f;
        for (int k = 1; k < win; ++k) s += bf2f(U[(15 - k) * 512 + c]);
#pragma unroll 8
        for (int ii = 0; ii < 64; ++ii) { const int tl = tl0 + ii;
            const float cur = bf2f(U[(15 + ii) * 512 + c]); s += cur;
            const int cnt = (tl + 1 < win) ? (tl + 1) : win;
            Mm[ii * 520 + c] = f2bf(s * __builtin_amdgcn_rcpf((float)cnt) - cur);
            s -= bf2f(U[(15 + ii - (win - 1)) * 512 + c]); }
        __syncthreads();
        const int g = w >> 1;
        const bf16_t* WpT = (const bf16_t*)(wsb + WS_WPOOL) + (size_t)(l * 4 + g) * 16384;
        bf16x8 af[2][4];
#pragma unroll
        for (int m2 = 0; m2 < 2; ++m2)
#pragma unroll
            for (int ks = 0; ks < 4; ++ks) af[m2][ks] = *(const LAS bf16x8*)(Mm + (16 * (2 * (w & 1) + m2) + lr) * 520 + g * 128 + ks * 32 + 8 * q4);
#pragma unroll
        for (int nh = 0; nh < 2; ++nh) {
            bf16x8 bfr[4][4]; u32x2 gq[2][4]; f32x4 psc[4];
#pragma unroll
            for (int n2 = 0; n2 < 4; ++n2) { const bf16_t* bp = WpT + (size_t)(16 * (nh * 4 + n2) + lr) * 128 + 8 * q4;
#pragma unroll
                for (int ks = 0; ks < 4; ++ks) bfr[n2][ks] = *(const bf16x8*)(bp + ks * 32);
                const int col = g * 128 + 16 * (nh * 4 + n2) + 4 * q4;
                psc[n2] = *(const f32x4*)(p.pool_scale + l * 512 + col);
#pragma unroll
                for (int m2 = 0; m2 < 2; ++m2) gq[m2][n2] = __builtin_nontemporal_load((const u32x2*)((const bf16_t*)(wsb + WS_G2) + g2_index((size_t)R0 + 16 * (2 * (w & 1) + m2) + lr, col))); }
            __builtin_amdgcn_sched_barrier(0);
#pragma unroll
            for (int m2 = 0; m2 < 2; ++m2)
#pragma unroll
                for (int n2 = 0; n2 < 4; ++n2) {
                    f32x4 acc = {0.f, 0.f, 0.f, 0.f};
#pragma unroll
                    for (int ks = 0; ks < 4; ++ks) acc = __builtin_amdgcn_mfma_f32_16x16x32_bf16(bfr[n2][ks], af[m2][ks], acc, 0, 0, 0);
                    const size_t row = (size_t)R0 + 16 * (2 * (w & 1) + m2) + lr; const int col = g * 128 + 16 * (nh * 4 + n2) + 4 * q4;
                    const u32x2 gg = gq[m2][n2];
                    const float g0 = __uint_as_float(gg.x << 16), g1 = __uint_as_float(gg.x & 0xffff0000u), g2 = __uint_as_float(gg.y << 16), g3 = __uint_as_float(gg.y & 0xffff0000u);
                    u32x2 o; o.x = cvt_pk_bf16(acc[0] * psc[n2][0] * silu_f(g0), acc[1] * psc[n2][1] * silu_f(g1)); o.y = cvt_pk_bf16(acc[2] * psc[n2][2] * silu_f(g2), acc[3] * psc[n2][3] * silu_f(g3));
                    *(u32x2*)(MIX + mixf_index(row, col)) = o;
                }
        }
        __syncthreads();
    }
    if ((R0 >> 6) & 1) retention_part<4>(p, R0, w, q4, lr); else retention_part<2>(p, R0, w, q4, lr);
}

__device__ void mini_gemm_task(const Params& p_, int l, int t, LAS unsigned char* lds) {
    const Params p = gp(p_);
    unsigned char* const wsb = ows(p.ws);
    const int tid = otid(), w = __builtin_amdgcn_readfirstlane(tid >> 6), lane = tid & 63, q4 = lane >> 4, lr = lane & 15;
    const int tm = t >> 4, tn = t & 15, mp = w & 1, nh = (w >> 1) & 1, kh = w >> 2;
    constexpr int MGP = 2048 + 64;
    LAS unsigned char* const As = lds + 16384;
    {
        const bf16_t* src = (const bf16_t*)(wsb + WS_MIX) + ((size_t)NP + 64 * tm) * DM;
        u32x4 vv[16];
#pragma unroll
        for (int k = 0; k < 16; ++k) { const int pi = tid + k * NTHREADS; vv[k] = *(const u32x4*)(src + (size_t)(pi >> 7) * DM + (pi & 127) * 8); }
#pragma unroll
        for (int k = 0; k < 16; ++k) { const int pi = tid + k * NTHREADS; *(LAS u32x4*)(As + (pi >> 7) * MGP + (pi & 127) * 16) = vv[k]; }
        __syncthreads();
    }
    const LAS unsigned char* ap0 = As + (32 * mp + lr) * MGP + (512 * kh + 8 * q4) * 2;
    const LAS unsigned char* ap1 = ap0 + 16 * MGP;
    const bf16_t* bp0 = (const bf16_t*)(wsb + WS_WO) + (size_t)l * DM * DM + ((size_t)((tn * 4 + 2 * nh) * 32 + 16 * kh) * 64 + lane) * 8;
    const bf16_t* bp1 = bp0 + 32 * 512;
    f32x4 acc[2][2];
#pragma unroll
    for (int i = 0; i < 2; ++i)
#pragma unroll
        for (int j = 0; j < 2; ++j) acc[i][j] = (f32x4){0.f, 0.f, 0.f, 0.f};
    bf16x8 fa0[2][4], fa1[2][4], fb0[2][4], fb1[2][4];
#define MG_LOAD(s_, kb) do { _Pragma("unroll") for (int k = 0; k < 4; ++k) { fa0[s_][k] = *(const LAS bf16x8*)(ap0 + ((kb) * 4 + k) * 64); fa1[s_][k] = *(const LAS bf16x8*)(ap1 + ((kb) * 4 + k) * 64); \
        fb0[s_][k] = *(const bf16x8*)(bp0 + ((kb) * 4 + k) * 512); fb1[s_][k] = *(const bf16x8*)(bp1 + ((kb) * 4 + k) * 512); } } while (0)
#define MG_MMA(s_) do { _Pragma("unroll") for (int k = 0; k < 4; ++k) { \
        acc[0][0] = __builtin_amdgcn_mfma_f32_16x16x32_bf16(fb0[s_][k], fa0[s_][k], acc[0][0], 0, 0, 0); acc[0][1] = __builtin_amdgcn_mfma_f32_16x16x32_bf16(fb1[s_][k], fa0[s_][k], acc[0][1], 0, 0, 0); \
        acc[1][0] = __builtin_amdgcn_mfma_f32_16x16x32_bf16(fb0[s_][k], fa1[s_][k], acc[1][0], 0, 0, 0); acc[1][1] = __builtin_amdgcn_mfma_f32_16x16x32_bf16(fb1[s_][k], fa1[s_][k], acc[1][1], 0, 0, 0); } } while (0)
    MG_LOAD(0, 0);
#pragma unroll
    for (int kb = 0; kb < 4; kb += 2) {
        MG_LOAD(1, kb + 1);
        __builtin_amdgcn_sched_barrier(0);
        MG_MMA(0);
        __builtin_amdgcn_sched_barrier(0);
        if (kb + 2 < 4) MG_LOAD(0, kb + 2);
        __builtin_amdgcn_sched_barrier(0);
        MG_MMA(1);
        __builtin_amdgcn_sched_barrier(0);
    }
#undef MG_LOAD
#undef MG_MMA
    LAS f32x4* red = (LAS f32x4*)lds;
    if (kh == 1) {
#pragma unroll
        for (int i = 0; i < 2; ++i)
#pragma unroll
            for (int j = 0; j < 2; ++j) red[((w & 3) * 4 + i * 2 + j) * 64 + lane] = acc[i][j];
    }
    __syncthreads();
    if (kh == 0) {
#pragma unroll
        for (int i = 0; i < 2; ++i) {
            float* yp = (float*)(wsb + WS_Y) + ((size_t)NP + 64 * tm + 32 * mp + 16 * i + lr) * DM + 64 * tn + 32 * nh + 4 * q4;
            *(f32x4*)yp = acc[i][0] + red[((w & 3) * 4 + i * 2 + 0) * 64 + lane]; *(f32x4*)(yp + 16) = acc[i][1] + red[((w & 3) * 4 + i * 2 + 1) * 64 + lane];
        }
    }
    __syncthreads();
}

__device__ void inproj_s_task(const Params& p_, int l, int t, LAS unsigned char* lds, bool stage_a) {
    const Params p = gp(p_);
    unsigned char* const wsb = ows(p.ws);
    const int tid = otid(), w = __builtin_amdgcn_readfirstlane(tid >> 6), lane = tid & 63, q4 = lane >> 4, lr = lane & 15;
    const int tm = t / 24, sn = t % 24, jn = w & 3, kh = w >> 2;
    LAS unsigned char* const As = lds + 32768;
    if (stage_a) {
        const bf16_t* src = (const bf16_t*)(wsb + WS_HSF) + (size_t)(2 * tm) * 32 * 512;
        u32x4 vv[8];
#pragma unroll
        for (int k = 0; k < 8; ++k) vv[k] = *(const u32x4*)(src + (size_t)(tid + k * NTHREADS) * 8);
#pragma unroll
        for (int k = 0; k < 8; ++k) *(LAS u32x4*)(As + (tid + k * NTHREADS) * 16) = vv[k];
        __syncthreads();
    }
    const LAS unsigned char* ap0 = As + (16 * kh) * 1024 + lane * 16;
    const LAS unsigned char* ap1 = ap0 + 32 * 1024;
    const bf16_t* bp0 = (const bf16_t*)(wsb + WS_WINF) + (size_t)l * DIN * DM + ((size_t)((sn * 8 + jn) * 32 + 16 * kh) * 64 + lane) * 8;
    const bf16_t* bp1 = bp0 + (size_t)4 * 32 * 512;
    f32x4 acc[2][2];
#pragma unroll
    for (int i = 0; i < 2; ++i)
#pragma unroll
        for (int j = 0; j < 2; ++j) acc[i][j] = (f32x4){0.f, 0.f, 0.f, 0.f};
    bf16x8 fa0[2][4], fa1[2][4], fb0[2][4], fb1[2][4];
#define IS_LOAD(s_, kb) do { _Pragma("unroll") for (int k = 0; k < 4; ++k) { fa0[s_][k] = *(const LAS bf16x8*)(ap0 + ((kb) * 4 + k) * 1024); fa1[s_][k] = *(const LAS bf16x8*)(ap1 + ((kb) * 4 + k) * 1024); \
        fb0[s_][k] = *(const bf16x8*)(bp0 + ((kb) * 4 + k) * 512); fb1[s_][k] = *(const bf16x8*)(bp1 + ((kb) * 4 + k) * 512); } } while (0)
#define IS_MMA(s_) do { _Pragma("unroll") for (int k = 0; k < 4; ++k) { \
        acc[0][0] = __builtin_amdgcn_mfma_f32_16x16x32_bf16(fb0[s_][k], fa0[s_][k], acc[0][0], 0, 0, 0); acc[0][1] = __builtin_amdgcn_mfma_f32_16x16x32_bf16(fb1[s_][k], fa0[s_][k], acc[0][1], 0, 0, 0); \
        acc[1][0] = __builtin_amdgcn_mfma_f32_16x16x32_bf16(fb0[s_][k], fa1[s_][k], acc[1][0], 0, 0, 0); acc[1][1] = __builtin_amdgcn_mfma_f32_16x16x32_bf16(fb1[s_][k], fa1[s_][k], acc[1][1], 0, 0, 0); } } while (0)
    IS_LOAD(0, 0);
#pragma unroll
    for (int kb = 0; kb < 4; kb += 2) {
        IS_LOAD(1, kb + 1);
        __builtin_amdgcn_sched_barrier(0);
        IS_MMA(0);
        __builtin_amdgcn_sched_barrier(0);
        if (kb + 2 < 4) IS_LOAD(0, kb + 2);
        __builtin_amdgcn_sched_barrier(0);
        IS_MMA(1);
        __builtin_amdgcn_sched_barrier(0);
    }
#undef IS_LOAD
#undef IS_MMA
    LAS f32x4* red = (LAS f32x4*)lds;
    if (kh == 1) {
#pragma unroll
        for (int i = 0; i < 2; ++i)
#pragma unroll
            for (int j = 0; j < 2; ++j) red[(jn * 4 + i * 2 + j) * 64 + lane] = acc[i][j];
    }
    __syncthreads();
    if (kh == 0) {
#pragma unroll
        for (int mt = 0; mt < 2; ++mt) {
            const int rs = 32 * tm + 16 * mt + lr, row = NP + rs, colb = 128 * sn, d0 = 16 * jn + 4 * q4;
            f32x4 v0 = acc[mt][0] + red[(jn * 4 + mt * 2 + 0) * 64 + lane], v1 = acc[mt][1] + red[(jn * 4 + mt * 2 + 1) * 64 + lane];
            if (sn >= 4 && sn < 12) {
                const int tpos = 2048 + (rs & 7);
                const f32x4 c4 = *(const f32x4*)((const float*)(wsb + WS_COS) + tpos * 64 + d0), s4 = *(const f32x4*)((const float*)(wsb + WS_SIN) + tpos * 64 + d0);
                f32x4 r0 = v0 * c4 - v1 * s4, r1 = v0 * s4 + v1 * c4;
                if (sn >= 8) { r0 *= 0.08838834764831845f; r1 *= 0.08838834764831845f; }
                v0 = r0; v1 = r1;
            }
            u32x2 w0, w1; w0.x = cvt_pk_bf16(v0[0], v0[1]); w0.y = cvt_pk_bf16(v0[2], v0[3]); w1.x = cvt_pk_bf16(v1[0], v1[1]); w1.y = cvt_pk_bf16(v1[2], v1[3]);
            bf16_t* zp = (bf16_t*)(wsb + WS_ZB) + (size_t)row * DIN + colb + d0;
            *(u32x2*)zp = w0; *(u32x2*)(zp + 64) = w1;
            if (sn < 4) { float* pp = p.out + OUT_POOLS + (size_t)l * SB * 15 * 512 + ((size_t)((rs >> 3) * 15 + 7 + (rs & 7))) * 512 + colb + d0; *(f32x4*)pp = v0; *(f32x4*)(pp + 64) = v1; }
        }
    }
    __syncthreads();
}

__device__ void fusedp_task(const Params& p_, int l, int tile, LAS unsigned char* lds) {
    const Params p = gp(p_);
    unsigned char* const wsb = ows(p.ws);
    const int tid = otid(), w = __builtin_amdgcn_readfirstlane(tid >> 6), lane = tid & 63, q4 = lane >> 4, lr = lane & 15;
    const int R0 = tile * 64, brow = R0 >> 11;
    const bf16_t* MIX = (const bf16_t*)(wsb + WS_MIX); const bf16_t* WoT = (const bf16_t*)(wsb + WS_WO) + (size_t)l * DM * DM;
    const float* mod = (const float*)(wsb + WS_MOD); float* XR = (float*)(wsb + WS_XR); bf16_t* H = (bf16_t*)(wsb + WS_H);
    const bf16_t* bp = WoT + ((size_t)(w * 8) * 32 * 64 + lane) * 8;
    bf16x8 B0[8], B1[8];
#define FP_LOADB(dst, kk) do { _Pragma("unroll") for (int nt = 0; nt < 8; ++nt) dst[nt] = *(const bf16x8*)(bp + (size_t)(nt * 32 + (kk)) * 512); } while (0)
    FP_LOADB(B0, 0);
    LAS unsigned char* At = lds;
    {
        const bf16_t* src = MIX + (size_t)(R0 >> 4) * 32 * 512;
        u32x4 v[16];
#pragma unroll
        for (int k = 0; k < 16; ++k) v[k] = __builtin_nontemporal_load((const u32x4*)(src + (size_t)(tid + k * NTHREADS) * 8));
#pragma unroll
        for (int k = 0; k < 16; ++k) *(LAS u32x4*)(At + (tid + k * NTHREADS) * 16) = v[k];
    }
    __syncthreads();
    f32x4 acc[4][8];
#pragma unroll
    for (int mt = 0; mt < 4; ++mt)
#pragma unroll
        for (int nt = 0; nt < 8; ++nt) acc[mt][nt] = (f32x4){0.f, 0.f, 0.f, 0.f};
#define FP_STEP(Bx, kk) do { bf16x8 Af[4]; \
        _Pragma("unroll") for (int mt = 0; mt < 4; ++mt) Af[mt] = *(const LAS bf16x8*)(At + (mt * 32 + (kk)) * 1024 + lane * 16); \
        _Pragma("unroll") for (int mt = 0; mt < 4; ++mt) _Pragma("unroll") for (int nt = 0; nt < 8; ++nt) acc[mt][nt] = __builtin_amdgcn_mfma_f32_16x16x32_bf16(Bx[nt], Af[mt], acc[mt][nt], 0, 0, 0); } while (0)
#pragma unroll 1
    for (int ks = 0; ks < 32; ks += 2) {
        FP_LOADB(B1, ks + 1);
        __builtin_amdgcn_sched_barrier(0);
        FP_STEP(B0, ks);
        __builtin_amdgcn_sched_barrier(0);
        { const int kn = ks + 2 < 32 ? ks + 2 : 31; FP_LOADB(B0, kn); }
        __builtin_amdgcn_sched_barrier(0);
        FP_STEP(B1, ks + 1);
        __builtin_amdgcn_sched_barrier(0);
    }
#undef FP_LOADB
#undef FP_STEP
    constexpr int YP = 4096 + 64;
    const float* xin = (l == 0) ? p.x_prompt : (const float*)XR; float* xo = (l == DEPTH - 1) ? p.out : XR;
    f32x4 gg[4], aa[4], sh[4];
#pragma unroll
    for (int j = 0; j < 4; ++j) { const int col = lane * 4 + j * 256;
        gg[j] = *(const f32x4*)(mod + (size_t)brow * MODLD + l * 3072 + 2048 + col) * *(const f32x4*)(p.g_post + l * DM + col);
        if (l < DEPTH - 1) { aa[j] = *(const f32x4*)(p.g_pre + (l + 1) * DM + col) * (1.0f + *(const f32x4*)(mod + (size_t)brow * MODLD + (l + 1) * 3072 + 1024 + col));
            sh[j] = *(const f32x4*)(mod + (size_t)brow * MODLD + (l + 1) * 3072 + col); }
        else { aa[j] = (f32x4){0.f, 0.f, 0.f, 0.f}; sh[j] = (f32x4){0.f, 0.f, 0.f, 0.f}; } }
#define FP_LOADX(dst, half_, k2_) do { _Pragma("unroll") for (int k = 0; k < 2; ++k) { const size_t off_ = (size_t)(R0 + 32 * (half_) + 4 * w + 2 * (k2_) + k) * DM; \
        _Pragma("unroll") for (int j = 0; j < 4; ++j) dst[k][j] = __builtin_nontemporal_load((const f32x4*)(xin + off_ + lane * 4 + j * 256)); } } while (0)
#define FP_ROWS(xv, half_, k2_) do { _Pragma("unroll") for (int k = 0; k < 2; ++k) { const int rl = 4 * w + 2 * (k2_) + k; const size_t off = (size_t)(R0 + 32 * (half_) + rl) * DM; \
        f32x4 y[4]; float ss = 0.f; \
        _Pragma("unroll") for (int j = 0; j < 4; ++j) { y[j] = *(const LAS f32x4*)(lds + rl * YP + (lane * 4 + j * 256) * 4); ss += y[j][0] * y[j][0] + y[j][1] * y[j][1] + y[j][2] * y[j][2] + y[j][3] * y[j][3]; } \
        ss = wave_sum(ss); const float rsy = rsqrtf(ss * (1.0f / DM) + EPSN); \
        float sx = 0.f; \
        _Pragma("unroll") for (int j = 0; j < 4; ++j) { const f32x4 v = xv[k][j] + gg[j] * (y[j] * rsy); y[j] = v; __builtin_nontemporal_store(v, (f32x4*)(xo + off + lane * 4 + j * 256)); \
            sx += v[0] * v[0] + v[1] * v[1] + v[2] * v[2] + v[3] * v[3]; } \
        if (l < DEPTH - 1) { \
            sx = wave_sum(sx); const float rsx = rsqrtf(sx * (1.0f / DM) + EPSN); \
            _Pragma("unroll") for (int j = 0; j < 4; ++j) { const f32x4 hv = y[j] * rsx * aa[j] + sh[j]; \
                u32x2 o; o.x = cvt_pk_bf16(hv[0], hv[1]); o.y = cvt_pk_bf16(hv[2], hv[3]); \
                __builtin_nontemporal_store(o, (u32x2*)(H + off + lane * 4 + j * 256)); } } } } while (0)
    f32x4 xa[2][4], xb[2][4];
    FP_LOADX(xa, 0, 0);
#pragma unroll
    for (int half = 0; half < 2; ++half) {
        __syncthreads();
#pragma unroll
        for (int m2 = 0; m2 < 2; ++m2)
#pragma unroll
            for (int nt = 0; nt < 8; ++nt) *(LAS f32x4*)(lds + (16 * m2 + lr) * YP + (128 * w + 16 * nt + 4 * q4) * 4) = acc[2 * half + m2][nt];
        __syncthreads();
        FP_LOADX(xb, half, 1);
        __builtin_amdgcn_sched_barrier(0);
        FP_ROWS(xa, half, 0);
        __builtin_amdgcn_sched_barrier(0);
        if (half == 0) FP_LOADX(xa, 1, 0);
        __builtin_amdgcn_sched_barrier(0);
        FP_ROWS(xb, half, 1);
        __builtin_amdgcn_sched_barrier(0);
    }
#undef FP_LOADX
#undef FP_ROWS
    __syncthreads();
}

#define LOADP(q) Params q; { typedef void* const __attribute__((address_space(4)))* kp_t; kp_t kp_ = (kp_t)__builtin_amdgcn_kernarg_segment_ptr(); asm volatile("" : "+s"(kp_)); \
    q.x_prompt = (const float*)kp_[0]; q.x_sample = (const float*)kp_[1]; q.c_prompt = (const float*)kp_[2]; q.c_sample = (const float*)kp_[3]; q.state_ret = (const float*)kp_[4]; q.state_pool = (const float*)kp_[5]; \
    q.w_ada = (const float*)kp_[6]; q.b_ada = (const float*)kp_[7]; q.g_pre = (const float*)kp_[8]; q.g_post = (const float*)kp_[9]; q.w_in = (const float*)kp_[10]; q.w_pool = (const float*)kp_[11]; \
    q.pool_scale = (const float*)kp_[12]; q.w_o = (const float*)kp_[13]; q.out = (float*)kp_[14]; q.ws = (unsigned char*)kp_[15]; }

__global__ void __launch_bounds__(NTHREADS) fwd_megakernel(Params p_arg) {
    extern __shared__ __attribute__((aligned(16))) unsigned char lds_raw[];
    LAS unsigned char* lds = (LAS unsigned char*)lds_raw;
    cg::grid_group grid = cg::this_grid();
    const int G = gridDim.x, bx = blockIdx.x;
    volatile LAS unsigned* bst = (volatile LAS unsigned*)(lds + LDS_USER);
    if (threadIdx.x < 4) bst[threadIdx.x] = 0u;
    __syncthreads();
    const XcdBarrier xbar = xcd_barrier_post((unsigned*)(p_arg.ws + WS_BAR), bst);
#define GSYNC() xcd_barrier(xbar)

    { LOADP(p); phase_prep(p, lds); }
    grid.sync();
    {   LOADP(p);
        pg8::Gemm g{(const bf16_t*)(p.ws + WS_SC), (const bf16_t*)(p.ws + WS_WADA), 256, MODLD, DM};
        pg8::StaticOrder S; S.init(256, MODLD, G, bx);
        pg8::EpiF32 E{(float*)(p.ws + WS_MOD), MODLD, p.b_ada};
        pg8::gemm_phase<pg8::EpiF32, pg8::StaticOrder>(lds, g, S, E);
    }
    GSYNC();
    { LOADP(p); phase_rows(p, -1, 0, 0, NTOK); }
    GSYNC();
#pragma unroll 1
    for (int l = 0; l < DEPTH; ++l) {
        {   LOADP(p);
            pg8::Gemm g{(const bf16_t*)(p.ws + WS_H), (const bf16_t*)(p.ws + WS_WIN) + (size_t)l * DIN * DM, NP, DIN, DM};
            pg8::StaticOrder S; S.init(NP, DIN, G, bx);
            pg8::EpiZ E{p.ws, p.out + OUT_POOLP + (size_t)l * NB * 15 * 512, p.out + OUT_POOLS + (size_t)l * SB * 15 * 512};
            pg8::gemm_phase<pg8::EpiZ, pg8::StaticOrder>(lds, g, S, E);
        }
        { LOADP(p); int prev_tm = -1; for (int t = bx; t < 32 * 24; t += G) { const int r = t >> 8, c = t & 255, x = c & 7, i = c >> 3; inproj_s_task(p, l, i * 24 + x * 3 + r, lds, i != prev_tm); prev_tm = i; } }
        GSYNC();
        { LOADP(p); for (int t = bx; t < 256; t += G) { const int x = t & 7, i = t >> 3; kvscan_task(p, l, (x * 4 + (i >> 3)) * 8 + (i & 7), lds); } }
        { LOADP(p); for (int t = bx; t < 512; t += G) rs_task(p, l, t, lds); }
        GSYNC();
        { LOADP(p); for (int t = bx; t < NP / 64; t += G) { const int x = t & 7, i = t >> 3; mixer_task(p, l, 2 * (x * 16 + (i >> 1)) + (i & 1), lds); } }
        { LOADP(p); for (int t = bx; t < 256; t += G) { const int x = t & 7, i = t >> 3; mini_gemm_task(p, l, (i >> 1) * 16 + 2 * x + (i & 1), lds); } }
        GSYNC();
        { LOADP(p); for (int t = bx; t < NP / 64; t += G) fusedp_task(p, l, t, lds); }
        { LOADP(p); phase_rows(p, l, l + 1, NP, NTOK); }
        GSYNC();
    }
}

extern "C" void kernel_launch(void* const* d_in, const int* in_sizes, int n_in, void* d_out, int out_size, void* d_ws, size_t ws_size, hipStream_t stream) {
    static int grid_blocks = 0;
    if (grid_blocks == 0) {
        if (n_in != 14 || (size_t)out_size != OUT_END || ws_size < WS_END) { fprintf(stderr, "kernel_launch: unexpected shapes (n_in %d out %d ws %zu need %zu)\n", n_in, out_size, ws_size, (size_t)WS_END); grid_blocks = -1; return; }
        int dev = 0, cus = 0, per_cu = 0;
        (void)hipGetDevice(&dev);
        (void)hipDeviceGetAttribute(&cus, hipDeviceAttributeMultiprocessorCount, dev);
        if (hipFuncSetAttribute((const void*)fwd_megakernel, hipFuncAttributeMaxDynamicSharedMemorySize, LDS_BYTES) != hipSuccess) { fprintf(stderr, "kernel_launch: hipFuncSetAttribute failed\n"); grid_blocks = -1; return; }
        if (hipOccupancyMaxActiveBlocksPerMultiprocessor(&per_cu, (const void*)fwd_megakernel, NTHREADS, LDS_BYTES) != hipSuccess || per_cu < 1) { fprintf(stderr, "kernel_launch: occupancy query failed (%d)\n", per_cu); per_cu = 1; (void)hipGetLastError(); }
        grid_blocks = cus;
    }
    if (grid_blocks < 0) return;
    Params p{};
    p.x_prompt = (const float*)d_in[0]; p.x_sample = (const float*)d_in[1]; p.c_prompt = (const float*)d_in[2]; p.c_sample = (const float*)d_in[3];
    p.state_ret = (const float*)d_in[4]; p.state_pool = (const float*)d_in[5]; p.w_ada = (const float*)d_in[6]; p.b_ada = (const float*)d_in[7];
    p.g_pre = (const float*)d_in[8]; p.g_post = (const float*)d_in[9]; p.w_in = (const float*)d_in[10]; p.w_pool = (const float*)d_in[11];
    p.pool_scale = (const float*)d_in[12]; p.w_o = (const float*)d_in[13];
    p.out = (float*)d_out; p.ws = (unsigned char*)d_ws;
    if (hipMemsetAsync((char*)d_ws + WS_BAR, 0, XCD_BAR_WORDS * 4, stream) != hipSuccess) { fprintf(stderr, "kernel_launch: memset failed\n"); return; }
    void* args[] = {&p};
    hipError_t e = hipLaunchCooperativeKernel((const void*)fwd_megakernel, dim3(grid_blocks), dim3(NTHREADS), args, LDS_BYTES, stream);
    if (e != hipSuccess) fprintf(stderr, "cooperative launch failed: %s (grid %d)\n", hipGetErrorString(e), grid_blocks);
}
```

```cpp
#include <hip/hip_runtime.h>
#include <hip/hip_cooperative_groups.h>
#include <cstdio>
#include <cstdint>
namespace cg = cooperative_groups;

#define LAS __attribute__((address_space(3)))
typedef unsigned short bf16_t;
typedef short bf16x8 __attribute__((ext_vector_type(8)));
typedef float f32x4 __attribute__((ext_vector_type(4)));
typedef unsigned u32x4 __attribute__((ext_vector_type(4)));
typedef unsigned u32x2 __attribute__((ext_vector_type(2)));

constexpr int DM = 1024, NP = 16384, NS = 1024, NTOK = NP + NS, DIN = 3072, DEPTH = 4;
constexpr int LP = 2048, NB = 8, SB = 128, SL = 8;
constexpr int MODLD = DEPTH * 3 * DM;
constexpr float EPSN = 1e-6f;

__device__ __forceinline__ bf16_t f2bf(float f) { unsigned u = __float_as_uint(f); u += 0x7FFFu + ((u >> 16) & 1u); return (bf16_t)(u >> 16); }
__device__ __forceinline__ float bf2f(bf16_t b) { return __uint_as_float(((unsigned)b) << 16); }
__device__ __forceinline__ unsigned cvt_pk_bf16(float lo, float hi) { unsigned r; asm volatile("v_cvt_pk_bf16_f32 %0, %1, %2" : "=v"(r) : "v"(lo), "v"(hi)); return r; }
__device__ __forceinline__ float silu_f(float x) { return x * __builtin_amdgcn_rcpf(1.0f + __builtin_amdgcn_exp2f(-1.4426950408889634f * x)); }
__device__ __forceinline__ float fexp2(float x) { return __builtin_amdgcn_exp2f(x); }
__device__ __forceinline__ float lg2gamma(int h) { return log2f(1.0f - exp2f(-5.0f - (float)h)); }
__device__ __forceinline__ float wave_sum(float v) {
#pragma unroll
    for (int o = 32; o >= 1; o >>= 1) v += __shfl_xor(v, o);
    return v;
}

#define GAS __attribute__((address_space(1)))
__device__ __forceinline__ unsigned char* ows(unsigned char* w) { GAS unsigned char* g = (GAS unsigned char*)w; asm volatile("" : "+s"(g)); return (unsigned char*)g; }
template <class T> __device__ __forceinline__ T* as_global(T* q) { GAS T* g = (GAS T*)q; asm volatile("" : "+s"(g)); return (T*)g; }
__device__ __forceinline__ int otid() { int t = (int)threadIdx.x; asm volatile("" : "+v"(t)); return t; }

constexpr size_t al256(size_t x) { return (x + 255) & ~(size_t)255; }
constexpr size_t WS_WIN = 0;
constexpr size_t WS_WO = WS_WIN + al256((size_t)DEPTH * DIN * DM * 2);
constexpr size_t WS_WADA = WS_WO + al256((size_t)DEPTH * DM * DM * 2);
constexpr size_t WS_WPOOL = WS_WADA + al256((size_t)DEPTH * DIN * DM * 2);
constexpr size_t WS_SC = WS_WPOOL + al256((size_t)DEPTH * 4 * 128 * 128 * 2);
constexpr size_t WS_MOD = WS_SC + al256((size_t)256 * DM * 2);
constexpr size_t WS_COS = WS_MOD + al256((size_t)256 * MODLD * 4);
constexpr size_t WS_SIN = WS_COS + al256((size_t)2056 * 64 * 4);
constexpr size_t WS_H = WS_SIN + al256((size_t)2056 * 64 * 4);
constexpr size_t WS_ZB = WS_H + al256((size_t)NTOK * DM * 2);
constexpr size_t WS_KTD = WS_ZB + al256((size_t)NTOK * DIN * 2);
constexpr size_t WS_VT = WS_KTD + al256((size_t)NB * 4 * 128 * LP * 2);
constexpr size_t WS_SPT = WS_VT + al256((size_t)NB * 4 * 128 * LP * 2);
constexpr size_t WS_MIX = WS_SPT + al256((size_t)NB * 16 * 4 * 128 * 128 * 2);
constexpr size_t WS_Y = WS_MIX + al256((size_t)NTOK * DM * 2);
constexpr size_t WS_WINF = WS_Y;
constexpr size_t WS_HSF = WS_Y + ((size_t)32 << 20);
constexpr size_t WS_XR = WS_Y + al256((size_t)NTOK * DM * 4);
constexpr size_t WS_QF = WS_XR + al256((size_t)NTOK * DM * 4);
constexpr size_t WS_KF = WS_QF + al256((size_t)NP * 512 * 2);
constexpr size_t WS_G2 = WS_KF + al256((size_t)NP * 512 * 2);
constexpr size_t WS_BAR = WS_G2 + al256((size_t)NP * DM * 2);
constexpr size_t WS_END = WS_BAR + al256((size_t)3456 * 4);


__device__ __forceinline__ size_t mixf_index(size_t row, int col) { return ((size_t)((row >> 4) * 32 + (col >> 5)) * 64 + (((col >> 3) & 3) * 16 + (row & 15))) * 8 + (col & 7); }
__device__ __forceinline__ size_t g2_index(size_t row, int gc) { return ((size_t)((row >> 4) * 64 + (gc >> 4)) * 64 + (((gc >> 2) & 3) * 16 + (row & 15))) * 4 + (gc & 3); }

__device__ __forceinline__ size_t pf_index(int b, int h, int t, int e) {
    return ((size_t)((((b * 4 + h) * 16 + (t >> 7)) * 4 + ((t >> 5) & 3)) * 128 + e)) * 32 + (((t & 15) >> 2) * 8) + (((t >> 4) & 1) * 4) + (t & 3);
}

namespace pg8 {
constexpr int BM = 256, BK = 64, HALF = 128, HTB = HALF * BK * 2, STAGE_BYTES = 8 * HTB, NXCD = 8, WGM = 8;
__host__ __device__ __forceinline__ int lds_byte(int r, int c) { const int st = (r >> 4) * 2 + (c >> 5), rr = r & 15, cc = c & 31, ob = rr * 64 + cc * 2; return st * 1024 + (ob ^ (((ob >> 9) & 1) << 5)); }
__host__ __device__ __forceinline__ void stage_rc(int b, int& R, int& C) { const int st = b / 1024, sb = b % 1024, swz = sb ^ (((sb >> 9) & 1) << 5); R = (st >> 1) * 16 + swz / 64; C = (st & 1) * 32 + (swz % 64) / 2; }
struct Unit { int pm, pn; };
struct Gemm { const bf16_t* A; const bf16_t* Bt; int M, N, K; };
struct StaticOrder {
    int nM, nN, nwg, G, c;
    __host__ __device__ void init(int M, int N, int G_, int c_) { nM = M / BM; nN = N / BM; nwg = nM * nN; G = G_; c = c_; }
    __host__ __device__ bool next(int i, Unit& u) const {
        const long L = (long)i * G + c; if (L >= nwg) return false;
        int wgid = (int)L; { const int q = nwg / NXCD, r = nwg % NXCD, xcd = wgid % NXCD, off = wgid / NXCD; wgid = (xcd < r ? xcd * (q + 1) : r * (q + 1) + (xcd - r) * q) + off; }
        const int nig = WGM * nN, gid = wgid / nig, fm = gid * WGM, gsz = (nM - fm) < WGM ? (nM - fm) : WGM;
        u.pm = fm + ((wgid % nig) % gsz); u.pn = (wgid % nig) / gsz; return true;
    }
    __device__ __forceinline__ void a_ready(const Unit&) const {}
    __device__ __forceinline__ void done(const Unit&) const {}
};

struct EpiF32 {
    __host__ __device__ static __forceinline__ int bperm(int R) { return R; }
    float* C; int ldc; const float* bias;
    __device__ __forceinline__ void operator()(const f32x4 (&acc)[2][2][4][2], const Unit& u, int wr, int wc, int fr, int fq) const {
        const int row0 = u.pm * BM + wr * 64 + fr, col0 = u.pn * BM + wc * 32 + 4 * fq;
        f32x4 bv[2][2];
#pragma unroll
        for (int bj = 0; bj < 2; ++bj)
#pragma unroll
            for (int n = 0; n < 2; ++n) bv[bj][n] = bias ? *(const f32x4*)(bias + col0 + bj * HALF + n * 16) : (f32x4){0.f, 0.f, 0.f, 0.f};
#pragma unroll
        for (int ai = 0; ai < 2; ++ai)
#pragma unroll
            for (int m = 0; m < 4; ++m) { float* rowp = C + (size_t)(row0 + ai * HALF + m * 16) * ldc + col0;
#pragma unroll
                for (int bj = 0; bj < 2; ++bj)
#pragma unroll
                    for (int n = 0; n < 2; ++n) *(f32x4*)(rowp + bj * HALF + n * 16) = acc[ai][bj][m][n] + bv[bj][n]; }
    }
};

struct EpiZ {
    __host__ __device__ static __forceinline__ int bperm(int R) { return 64 * ((R >> 4) & 1) + 16 * (R >> 5) + (R & 15); }
    unsigned char* ws; float* poolP; float* poolS;
    __device__ __forceinline__ void operator()(const f32x4 (&acc)[2][2][4][2], const Unit& u, int wr, int wc, int fr, int fq) const {
        const int pn = u.pn; const bool prompt = u.pm < 64;
        unsigned char* const wsg = as_global(ws); float* const poolPg = as_global(poolP); float* const poolSg = as_global(poolS);
        bf16_t* const ZB = (bf16_t*)(wsg + WS_ZB); bf16_t* const KTD = (bf16_t*)(wsg + WS_KTD); bf16_t* const VT = (bf16_t*)(wsg + WS_VT); bf16_t* const QF = (bf16_t*)(wsg + WS_QF); bf16_t* const KF = (bf16_t*)(wsg + WS_KF);
        const float* const cosT = (const float*)(wsg + WS_COS); const float* const sinT = (const float*)(wsg + WS_SIN);
        const int d0 = wc * 16 + 4 * fq;
#pragma unroll
        for (int ai = 0; ai < 2; ++ai)
#pragma unroll
            for (int m = 0; m < 4; ++m) {
                const int row = u.pm * BM + ai * HALF + wr * 64 + m * 16 + fr;
                const int tpos = prompt ? (row & 2047) : (2048 + (row & 7));
#pragma unroll
                for (int bj = 0; bj < 2; ++bj) {
                    f32x4 v0 = acc[ai][bj][m][0], v1 = acc[ai][bj][m][1];
                    const int colb = pn * BM + bj * HALF;
                    const int h = (pn & 1) * 2 + bj;
                    if (pn >= 2 && pn < 6) {
                        const f32x4 c4 = *(const f32x4*)(cosT + tpos * 64 + d0), s4 = *(const f32x4*)(sinT + tpos * 64 + d0);
                        f32x4 r0 = v0 * c4 - v1 * s4, r1 = v0 * s4 + v1 * c4;
                        if (pn >= 4) { r0 *= 0.08838834764831845f; r1 *= 0.08838834764831845f; }
                        v0 = r0; v1 = r1;
                    }
                    u32x2 w0, w1; w0.x = cvt_pk_bf16(v0[0], v0[1]); w0.y = cvt_pk_bf16(v0[2], v0[3]); w1.x = cvt_pk_bf16(v1[0], v1[1]); w1.y = cvt_pk_bf16(v1[2], v1[3]);
                    if (prompt && pn >= 2 && pn < 6) {
                        bf16_t* fp = (pn < 4 ? QF : KF) + ((size_t)((((row >> 4) * 4 + h) * 4 + (wc >> 1)) * 64 + (((2 * wc + (fq >> 1)) & 3) * 16 + fr))) * 8 + 4 * (fq & 1);
                        *(u32x2*)fp = w0; *(u32x2*)(fp + 2 * 512) = w1;
                    } else if (prompt && pn >= 8) {
                        bf16_t* gp = (bf16_t*)(wsg + WS_G2) + g2_index((size_t)row, colb - 2048 + d0);
                        *(u32x2*)gp = w0; *(u32x2*)(gp + 4 * 64 * 4) = w1;
                    } else if (!(prompt && pn >= 6 && pn < 8)) {
                        bf16_t* zp = ZB + (size_t)row * DIN + colb + d0;
                        *(u32x2*)zp = w0; *(u32x2*)(zp + 64) = w1;
                    }
                    if (prompt && pn >= 4 && pn < 6) {
                        const int b = row >> 11, t = row & 2047;
                        const float dec = fexp2((float)(127 - (t & 127)) * lg2gamma(h));
                        bf16_t* kp = KTD + pf_index(b, h, t, d0);
#pragma unroll
                        for (int j = 0; j < 4; ++j) { kp[j * 32] = f2bf(v0[j] * dec); kp[(64 + j) * 32] = f2bf(v1[j] * dec); }
                    }
                    if (prompt && pn >= 6 && pn < 8) {
                        const int b = row >> 11, t = row & 2047;
                        bf16_t* vp = VT + pf_index(b, h, t, d0);
#pragma unroll
                        for (int j = 0; j < 4; ++j) { vp[j * 32] = f2bf(v0[j]); vp[(64 + j) * 32] = f2bf(v1[j]); }
                    }
                    if (pn < 2) {
                        if (prompt) { const int b = row >> 11, t = row & 2047;
                            if (t >= 2033) { float* pp = poolPg + ((size_t)(b * 15 + (t - 2033))) * 512 + colb + d0; *(f32x4*)pp = v0; *(f32x4*)(pp + 64) = v1; } }
                        else { const int sb = (row - NP) >> 3, ts = row & 7;
                            float* pp = poolSg + ((size_t)(sb * 15 + 7 + ts)) * 512 + colb + d0; *(f32x4*)pp = v0; *(f32x4*)(pp + 64) = v1; }
                    }
                }
                asm volatile("" ::: "memory");
            }
    }
};

template <class Epi, class Sched>
__device__ __forceinline__ void gemm_phase(LAS unsigned char* lds, const Gemm g, const Sched& S, const Epi& E) {
    const int tid = otid(), wid = __builtin_amdgcn_readfirstlane(tid >> 6), lane = tid & 63, wr = wid >> 2, wc = wid & 3, fr = lane & 15, fq = lane >> 4;
    const int K = g.K, nt = K / BK;
    unsigned voffA[2], voffB[2];
#pragma unroll
    for (int i = 0; i < 2; ++i) { int R, C; stage_rc(tid * 16 + i * 8192, R, C); const int Rb = Epi::bperm(R);
        voffA[i] = (unsigned)(R * K + C) * 2u; voffB[i] = (unsigned)(Rb * K + C) * 2u; }
    const size_t kstep = (size_t)(BK * 2);
    const size_t hstep = (size_t)HALF * K * 2;
    const size_t tstep = 2 * hstep;
    const unsigned ldsw = (unsigned)wid * 1024u;
    const int aoff = lds_byte(wr * 64 + fr, fq * 8), boff = lds_byte(wc * 32 + fr, fq * 8);
#define PG8_SA(b, h) (((b) * 2 + (h)) * HTB)
#define PG8_SB(b, h) ((4 + (b) * 2 + (h)) * HTB)
#define PG8_STAGE(bufoff, gbase, voff) do { _Pragma("unroll") for (int _i = 0; _i < 2; ++_i) \
        __builtin_amdgcn_global_load_lds((const unsigned*)((const char*)(gbase) + (voff)[_i]), (LAS unsigned*)(lds + (bufoff) + ldsw + _i * 8192), 16, 0, 0); } while (0)
#define PG8_LDA(dst, b, h) do { _Pragma("unroll") for (int m = 0; m < 4; ++m) _Pragma("unroll") for (int k = 0; k < 2; ++k) dst[m][k] = *(const LAS bf16x8*)(lds + PG8_SA(b, h) + aoff + m * 2048 + k * 1024); } while (0)
#define PG8_LDB(dst, b, h) do { _Pragma("unroll") for (int n = 0; n < 2; ++n) _Pragma("unroll") for (int k = 0; k < 2; ++k) dst[n][k] = *(const LAS bf16x8*)(lds + PG8_SB(b, h) + boff + n * 2048 + k * 1024); } while (0)
#define PG8_MMA(ai, bj, At, Bt) do { __builtin_amdgcn_s_setprio(1); _Pragma("unroll") for (int m = 0; m < 4; ++m) _Pragma("unroll") for (int n = 0; n < 2; ++n) _Pragma("unroll") for (int k = 0; k < 2; ++k) \
        acc[ai][bj][m][n] = __builtin_amdgcn_mfma_f32_16x16x32_bf16(Bt[n][k], At[m][k], acc[ai][bj][m][n], 0, 0, 0); __builtin_amdgcn_s_setprio(0); } while (0)
#define PG8_WAIT_V(n) asm volatile("s_waitcnt vmcnt(" #n ")" ::: "memory")
#define PG8_WAIT_L(n) asm volatile("s_waitcnt lgkmcnt(" #n ")" ::: "memory")
#define PG8_BAR __builtin_amdgcn_s_barrier()
#define PG8_SCHED __builtin_amdgcn_sched_barrier(0)
    Unit cur, nxt; int ui = 0;
    if (!S.next(0, cur)) return;
    f32x4 acc[2][2][4][2];
#pragma unroll
    for (int a = 0; a < 2; ++a)
#pragma unroll
        for (int b = 0; b < 2; ++b)
#pragma unroll
            for (int m = 0; m < 4; ++m)
#pragma unroll
                for (int n = 0; n < 2; ++n) acc[a][b][m][n] = (f32x4){0.f, 0.f, 0.f, 0.f};
    bf16x8 At[4][2], B0[2][2], B1[2][2];
    const char* cA = (const char*)g.A + (size_t)cur.pm * tstep; const char* cB = (const char*)g.Bt + (size_t)cur.pn * tstep;
    S.a_ready(cur);
    PG8_STAGE(PG8_SB(0, 0), cB, voffB); PG8_STAGE(PG8_SA(0, 0), cA, voffA); PG8_STAGE(PG8_SB(0, 1), cB + hstep, voffB); PG8_STAGE(PG8_SA(0, 1), cA + hstep, voffA);
    if (wr == 1) PG8_BAR;
    PG8_WAIT_V(4); PG8_BAR;
    PG8_STAGE(PG8_SB(1, 0), cB + kstep, voffB); PG8_STAGE(PG8_SA(1, 0), cA + kstep, voffA); PG8_STAGE(PG8_SB(1, 1), cB + hstep + kstep, voffB);
    PG8_WAIT_V(6); PG8_BAR;
    for (;;) {
        const bool has_next = S.next(ui + 1, nxt);
        const char* nA = has_next ? (const char*)g.A + (size_t)nxt.pm * tstep : cA; const char* nB = has_next ? (const char*)g.Bt + (size_t)nxt.pn * tstep : cB;
        for (int t = 0; t < nt; t += 2) {
            const bool last = (t == nt - 2);
            const char* a1 = cA + (size_t)(t + 1) * kstep;
            const char* a2 = last ? nA : cA + (size_t)(t + 2) * kstep; const char* b2 = last ? nB : cB + (size_t)(t + 2) * kstep;
            const char* a3 = a2 + kstep; const char* b3 = b2 + kstep;
            if (last && has_next) S.a_ready(nxt);
            PG8_LDB(B0, 0, 0); PG8_SCHED; PG8_LDA(At, 0, 0); PG8_STAGE(PG8_SA(1, 1), a1 + hstep, voffA);
            PG8_WAIT_L(8); PG8_BAR; PG8_WAIT_L(0); PG8_MMA(0, 0, At, B0); PG8_BAR; PG8_SCHED;
            PG8_LDB(B1, 0, 1); PG8_STAGE(PG8_SB(0, 0), b2, voffB);
            PG8_BAR; PG8_WAIT_L(0); PG8_MMA(0, 1, At, B1); PG8_BAR;
            PG8_LDA(At, 0, 1); PG8_STAGE(PG8_SA(0, 0), a2, voffA);
            PG8_BAR; PG8_WAIT_L(0); PG8_MMA(1, 0, At, B0); PG8_BAR; PG8_SCHED;
            PG8_STAGE(PG8_SB(0, 1), b2 + hstep, voffB);
            PG8_WAIT_V(6); PG8_BAR; PG8_MMA(1, 1, At, B1); PG8_BAR;
            PG8_LDB(B0, 1, 0); PG8_SCHED; PG8_LDA(At, 1, 0); PG8_STAGE(PG8_SA(0, 1), a2 + hstep, voffA);
            PG8_WAIT_L(8); PG8_BAR; PG8_WAIT_L(0); PG8_MMA(0, 0, At, B0); PG8_BAR; PG8_SCHED;
            PG8_LDB(B1, 1, 1); PG8_STAGE(PG8_SB(1, 0), b3, voffB);
            PG8_BAR; PG8_WAIT_L(0); PG8_MMA(0, 1, At, B1); PG8_BAR;
            PG8_LDA(At, 1, 1); PG8_STAGE(PG8_SA(1, 0), a3, voffA);
            PG8_BAR; PG8_WAIT_L(0); PG8_MMA(1, 0, At, B0); PG8_BAR; PG8_SCHED;
            PG8_STAGE(PG8_SB(1, 1), b3 + hstep, voffB);
            PG8_WAIT_V(6); PG8_BAR; PG8_MMA(1, 1, At, B1); PG8_BAR;
        }
        E(acc, cur, wr, wc, fr, fq); S.done(cur);
        if (!has_next) break;
#pragma unroll
        for (int a = 0; a < 2; ++a)
#pragma unroll
            for (int b = 0; b < 2; ++b)
#pragma unroll
                for (int m = 0; m < 4; ++m)
#pragma unroll
                    for (int n = 0; n < 2; ++n) acc[a][b][m][n] = (f32x4){0.f, 0.f, 0.f, 0.f};
        cur = nxt; cA = nA; cB = nB; ++ui;
    }
    PG8_WAIT_V(0);
    if (wr == 0) PG8_BAR;
    PG8_BAR;
#undef PG8_SA
#undef PG8_SB
#undef PG8_STAGE
#undef PG8_LDA
#undef PG8_LDB
#undef PG8_MMA
#undef PG8_WAIT_V
#undef PG8_WAIT_L
#undef PG8_BAR
#undef PG8_SCHED
}
}


#define XB_TMO      128
#define XB_XCNT(j)  (256  + 64 * (j))
#define XB_XSUB(j)  (1280 + 64 * (j))
#define XB_XGEN(j)  (2304 + 64 * (j))
#define XB_TOP      3328
#define XB_TOPGEN   3392
#define XCD_BAR_WORDS 3456
#define XB_SPIN_CAP (1u << 18)
__device__ __forceinline__ unsigned xb_ld(unsigned* p)              { return __hip_atomic_load(p, __ATOMIC_RELAXED, __HIP_MEMORY_SCOPE_AGENT); }
__device__ __forceinline__ unsigned xb_add(unsigned* p, unsigned v) { return __hip_atomic_fetch_add(p, v, __ATOMIC_RELAXED, __HIP_MEMORY_SCOPE_AGENT); }
__device__ __forceinline__ unsigned xb_xcc_id() { return (unsigned)__builtin_amdgcn_s_getreg((3 << 11) | 20) & 0xFu; }
#define XB_SPIN(cond, bar) do { unsigned _sp = 0; while (cond) { __builtin_amdgcn_s_sleep(1); \
    if ((++_sp & 255u) == 0u) { if (xb_ld(&(bar)[XB_TMO])) break; if (_sp > XB_SPIN_CAP) { atomicAdd(&(bar)[XB_TMO], 1u); break; } } } } while (0)
struct XcdBarrier { unsigned* bar; unsigned x; volatile LAS unsigned* st; };
__device__ __forceinline__ XcdBarrier xcd_barrier_post(unsigned* bar, volatile LAS unsigned* st) {
    XcdBarrier b; b.bar = bar; b.x = xb_xcc_id(); b.st = st;
    if (threadIdx.x == 0) (void)xb_add(&bar[XB_XCNT(b.x)], 1u);
    return b;
}
__device__ __forceinline__ void xcd_barrier_complete(unsigned* bar, unsigned x, unsigned& nloc, unsigned& nx) {
    const unsigned G = gridDim.x * gridDim.y * gridDim.z;
    unsigned sum, cnt, mine, sp = 0u;
    for (;;) {
        sum = 0u; cnt = 0u; mine = 0u;
#pragma unroll
        for (unsigned j = 0; j < 16; ++j) { const unsigned c = xb_ld(&bar[XB_XCNT(j)]); sum += c; cnt += (c > 0u) ? 1u : 0u; mine = (j == x) ? c : mine; }
        if (sum == G) break;
        __builtin_amdgcn_s_sleep(1);
        if ((++sp & 255u) == 0u) { if (xb_ld(&bar[XB_TMO])) break; if (sp > XB_SPIN_CAP) { atomicAdd(&bar[XB_TMO], 1u); break; } }
    }
    nloc = mine > 0u ? mine : 1u; nx = cnt > 0u ? cnt : 1u;
}
__device__ __forceinline__ void xcd_barrier(const XcdBarrier& b) {
    asm volatile("s_waitcnt vmcnt(0)" ::: "memory");
    __syncthreads();
    if (threadIdx.x == 0) {
        unsigned* bar = b.bar;
        __builtin_amdgcn_s_waitcnt(0);
        unsigned nloc = b.st[0], nx = b.st[1];
        if (nloc == 0u) { xcd_barrier_complete(bar, b.x, nloc, nx); b.st[0] = nloc; b.st[1] = nx; }
        const unsigned old = xb_add(&bar[XB_XSUB(b.x)], 1u);
        const unsigned gen = old / nloc;
        if (old + 1u == (gen + 1u) * nloc) {
            __builtin_amdgcn_fence(__ATOMIC_RELEASE, "agent");
            asm volatile("s_waitcnt vmcnt(0)" ::: "memory");
            const unsigned og = xb_add(&bar[XB_TOP], 1u);
            const unsigned tg = og / nx;
            if (og + 1u == (tg + 1u) * nx) xb_add(&bar[XB_TOPGEN], 1u);
            else XB_SPIN(xb_ld(&bar[XB_TOPGEN]) == tg, bar);
            __builtin_amdgcn_fence(__ATOMIC_ACQUIRE, "agent");
            xb_add(&bar[XB_XGEN(b.x)], 1u);
            asm volatile("s_waitcnt vmcnt(0)" ::: "memory");
        } else {
            XB_SPIN(xb_ld(&bar[XB_XGEN(b.x)]) == gen, bar);
            __builtin_amdgcn_fence(__ATOMIC_ACQUIRE, "agent");
            asm volatile("s_waitcnt vmcnt(0)" ::: "memory");
        }
    }
    __syncthreads();
}

struct Params {
    const float* x_prompt; const float* x_sample; const float* c_prompt; const float* c_sample;
    const float* state_ret; const float* state_pool; const float* w_ada; const float* b_ada;
    const float* g_pre; const float* g_post; const float* w_in; const float* w_pool; const float* pool_scale; const float* w_o;
    float* out; unsigned char* ws;
};
__device__ __forceinline__ Params gp(const Params& q) { return q; }
constexpr size_t OUT_YP = 0;
constexpr size_t OUT_YS = OUT_YP + (size_t)NP * DM;
constexpr size_t OUT_RETP = OUT_YS + (size_t)NS * DM;
constexpr size_t OUT_POOLP = OUT_RETP + (size_t)DEPTH * NB * 4 * 128 * 128;
constexpr size_t OUT_RETS = OUT_POOLP + (size_t)DEPTH * NB * 15 * 512;
constexpr size_t OUT_POOLS = OUT_RETS + (size_t)DEPTH * SB * 4 * 128 * 128;
constexpr size_t OUT_END = OUT_POOLS + (size_t)DEPTH * SB * 15 * 512;

constexpr int NTHREADS = 512;
constexpr int LDS_USER = 160 * 1024 - 16;
constexpr int LDS_BYTES = 160 * 1024;

struct TcTile { const float* src; bf16_t* dst; int R, C, tr, tc; bool frag; bf16_t* dst2; };
__device__ __forceinline__ TcTile tc_decode(const Params& p_, int t) {
    const Params p = gp(p_);
    unsigned char* const wsb = ows(p.ws);
    bf16_t* WinT = (bf16_t*)(wsb + WS_WIN); bf16_t* WoT = (bf16_t*)(wsb + WS_WO); bf16_t* WadaT = (bf16_t*)(wsb + WS_WADA); bf16_t* WpT = (bf16_t*)(wsb + WS_WPOOL);
    const int T1 = 3072, T2 = 6144, T3 = 7168;
    TcTile x;
    if (t < T1) { const int l = t / 768, r = t % 768; x = TcTile{p.w_in + (size_t)l * DM * DIN, WinT + (size_t)l * DIN * DM, DM, DIN, r / 48, r % 48, false, (bf16_t*)(wsb + WS_WINF) + (size_t)l * DIN * DM}; }
    else if (t < T2) { const int q = t - T1, l = q / 768, r = q % 768; x = TcTile{p.w_ada + (size_t)l * DM * DIN, WadaT + (size_t)l * DIN * DM, DM, DIN, r / 48, r % 48, false, nullptr}; }
    else if (t < T3) { const int q = t - T2, l = q / 256, r = q % 256; x = TcTile{p.w_o + (size_t)l * DM * DM, WoT + (size_t)l * DM * DM, DM, DM, r / 16, r % 16, true, nullptr}; }
    else { const int q = t - T3, m = q / 4, r = q % 4; x = TcTile{p.w_pool + (size_t)m * 128 * 128, WpT + (size_t)m * 128 * 128, 128, 128, r / 2, r % 2, false, nullptr}; }
    return x;
}

__device__ void phase_prep(const Params& p_, LAS unsigned char* lds) {
    const Params p = gp(p_);
    unsigned char* const wsb = ows(p.ws);
    LAS float* tile = (LAS float*)lds;
    const int tid = otid();
    const int T4 = 7232;
    for (int t0 = blockIdx.x * 4; t0 < T4; t0 += gridDim.x * 4) {
        f32x4 va[4], vb[4];
        const int r = tid >> 3, c0 = (tid & 7) * 8;
#pragma unroll
        for (int q = 0; q < 4; ++q) { const TcTile x = tc_decode(p, t0 + q);
            const float* sp = x.src + (size_t)(x.tr * 64 + r) * x.C + x.tc * 64 + c0;
            va[q] = __builtin_nontemporal_load((const f32x4*)sp); vb[q] = __builtin_nontemporal_load((const f32x4*)(sp + 4)); }
#pragma unroll
        for (int q = 0; q < 4; ++q) { LAS float* tl = tile + q * 64 * 65;
#pragma unroll
            for (int k = 0; k < 4; ++k) { tl[(c0 + k) * 65 + r] = va[q][k]; tl[(c0 + 4 + k) * 65 + r] = vb[q][k]; } }
        __syncthreads();
#pragma unroll
        for (int q = 0; q < 4; ++q) { const TcTile x = tc_decode(p, t0 + q); LAS float* tl = tile + q * 64 * 65;
            const int cc = tid >> 3, r8 = (tid & 7) * 8;
            u32x4 wv;
            wv.x = cvt_pk_bf16(tl[cc * 65 + r8 + 0], tl[cc * 65 + r8 + 1]); wv.y = cvt_pk_bf16(tl[cc * 65 + r8 + 2], tl[cc * 65 + r8 + 3]);
            wv.z = cvt_pk_bf16(tl[cc * 65 + r8 + 4], tl[cc * 65 + r8 + 5]); wv.w = cvt_pk_bf16(tl[cc * 65 + r8 + 6], tl[cc * 65 + r8 + 7]);
            const int n = x.tc * 64 + cc, k = x.tr * 64 + r8;
            const size_t di = x.frag ? ((size_t)(((n >> 4) * 32 + (k >> 5)) * 64 + (((k >> 3) & 3) * 16 + (n & 15)))) * 8 : (size_t)n * x.R + k;
            *(u32x4*)(x.dst + di) = wv;
            if (x.dst2) *(u32x4*)(x.dst2 + ((size_t)(((n >> 4) * 32 + (k >> 5)) * 64 + (((k >> 3) & 3) * 16 + (n & 15)))) * 8) = wv; }
        __syncthreads();
    }
    const int gtid = blockIdx.x * NTHREADS + otid(), gn = gridDim.x * NTHREADS;
    bf16_t* SC = (bf16_t*)(wsb + WS_SC);
    for (int i = gtid; i < 256 * DM; i += gn) { const int r = i >> 10, k = i & 1023;
        float v = 0.f; if (r < NB) v = silu_f(p.c_prompt[r * DM + k]); else if (r < NB + SB) v = silu_f(p.c_sample[(r - NB) * DM + k]);
        SC[i] = f2bf(v); }
    float* cosT = (float*)(wsb + WS_COS); float* sinT = (float*)(wsb + WS_SIN);
    for (int i = gtid; i < 2056 * 64; i += gn) { const int tp = i >> 6, f = i & 63;
        const float pos = (float)(tp < 2048 ? tp : (16384 + tp - 2048));
        const float inv = 1.0f / powf(10000.0f, (float)f * (1.0f / 64.0f));
        const float ang = pos * inv;
        const double a = (double)ang; const double kq = rint(a * 0.63661977236758134308); const double r = a - kq * 1.57079632679489661923;
        const double r2 = r * r;
        const double sn = r * (1.0 + r2 * (-1.0 / 6 + r2 * (1.0 / 120 + r2 * (-1.0 / 5040 + r2 * (1.0 / 362880 + r2 * (-1.0 / 39916800))))));
        const double cs = 1.0 + r2 * (-0.5 + r2 * (1.0 / 24 + r2 * (-1.0 / 720 + r2 * (1.0 / 40320 + r2 * (-1.0 / 3628800 + r2 * (1.0 / 479001600))))));
        const int qd = ((int)(long long)kq) & 3;
        double c, s; if (qd == 0) { c = cs; s = sn; } else if (qd == 1) { c = -sn; s = cs; } else if (qd == 2) { c = -cs; s = -sn; } else { c = sn; s = -cs; }
        cosT[i] = (float)c; sinT[i] = (float)s; }
}

__device__ void phase_rows(const Params& p_, int l_prev, int l_next, int row_lo, int row_hi) {
    const Params p = gp(p_);
    unsigned char* const wsb = ows(p.ws);
    const int tid0 = otid(); const int wave = tid0 >> 6, lane = tid0 & 63;
    const float* mod = (const float*)(wsb + WS_MOD); const float* Y = (const float*)(wsb + WS_Y);
    float* XR = (float*)(wsb + WS_XR); bf16_t* H = (bf16_t*)(wsb + WS_H);
    for (int row = row_lo + blockIdx.x * 8 + wave; row < row_hi; row += gridDim.x * 8) {
        const int brow = row < NP ? (row >> 11) : (NB + ((row - NP) >> 3));
        const float* xin = (l_prev <= 0) ? (row < NP ? p.x_prompt + (size_t)row * DM : p.x_sample + (size_t)(row - NP) * DM) : XR + (size_t)row * DM;
        f32x4 x[4];
#pragma unroll
        for (int j = 0; j < 4; ++j) x[j] = __builtin_nontemporal_load((const f32x4*)(xin + lane * 4 + j * 256));
        if (l_prev >= 0) {
            f32x4 y[4]; float ss = 0.f;
#pragma unroll
            for (int j = 0; j < 4; ++j) { y[j] = __builtin_nontemporal_load((const f32x4*)(Y + (size_t)row * DM + lane * 4 + j * 256)); ss += y[j][0] * y[j][0] + y[j][1] * y[j][1] + y[j][2] * y[j][2] + y[j][3] * y[j][3]; }
            ss = wave_sum(ss); const float rstd = rsqrtf(ss * (1.0f / DM) + EPSN);
            float* xo = (l_prev == DEPTH - 1) ? p.out + (size_t)row * DM : XR + (size_t)row * DM;
#pragma unroll
            for (int j = 0; j < 4; ++j) { const int col = lane * 4 + j * 256;
                const f32x4 gr = *(const f32x4*)(mod + (size_t)brow * MODLD + l_prev * 3072 + 2048 + col), gp = *(const f32x4*)(p.g_post + l_prev * DM + col);
                x[j] = x[j] + gr * (y[j] * rstd * gp); *(f32x4*)(xo + col) = x[j]; }
        }
        if (l_next < DEPTH) {
            float ss = 0.f;
#pragma unroll
            for (int j = 0; j < 4; ++j) ss += x[j][0] * x[j][0] + x[j][1] * x[j][1] + x[j][2] * x[j][2] + x[j][3] * x[j][3];
            ss = wave_sum(ss); const float rstd = rsqrtf(ss * (1.0f / DM) + EPSN);
#pragma unroll
            for (int j = 0; j < 4; ++j) { const int col = lane * 4 + j * 256;
                const f32x4 sh = *(const f32x4*)(mod + (size_t)brow * MODLD + l_next * 3072 + col), sc = *(const f32x4*)(mod + (size_t)brow * MODLD + l_next * 3072 + 1024 + col), gp = *(const f32x4*)(p.g_pre + l_next * DM + col);
                const f32x4 hv = x[j] * rstd * gp * (1.0f + sc) + sh;
                u32x2 w; w.x = cvt_pk_bf16(hv[0], hv[1]); w.y = cvt_pk_bf16(hv[2], hv[3]);
                if (row < NP) *(u32x2*)(H + (size_t)row * DM + col) = w;
                else *(u32x2*)((bf16_t*)(wsb + WS_HSF) + mixf_index((size_t)(row - NP), col)) = w; }
        }
    }
}

__device__ void kvscan_task(const Params& p_, int l, int task, LAS unsigned char* lds) {
    const Params p = gp(p_);
    unsigned char* const wsb = ows(p.ws);
    const int tid0 = otid(); const int wave = __builtin_amdgcn_readfirstlane(tid0 >> 6), lane = tid0 & 63, q4 = lane >> 4, lr = lane & 15;
    const int bh = task >> 3, es = task & 7, h = bh & 3, b = bh >> 2;
    const bf16_t* KTD = (const bf16_t*)(wsb + WS_KTD); const bf16_t* VT = (const bf16_t*)(wsb + WS_VT); bf16_t* SPT = (bf16_t*)(wsb + WS_SPT);
    const bf16_t* ka = KTD + (size_t)bh * 16 * 4 * 128 * 32 + (16 * wave + lr) * 32 + 8 * q4;
    const float g128 = fexp2(128.0f * lg2gamma(h));
    f32x4 S = {0.f, 0.f, 0.f, 0.f};
    const int e = 16 * es + lr, d0 = 16 * wave + 4 * q4;
    {
        u32x4 vv[8];
#pragma unroll
        for (int k = 0; k < 8; ++k) { const int pi = tid0 + k * NTHREADS; vv[k] = *(const u32x4*)(VT + (size_t)bh * 16 * 4 * 128 * 32 + (size_t)(pi >> 6) * 4096 + es * 512 + (pi & 63) * 8); }
#pragma unroll
        for (int k = 0; k < 8; ++k) { const int pi = tid0 + k * NTHREADS; *(LAS u32x4*)(lds + pi * 16) = vv[k]; }
        __syncthreads();
    }
    bf16x8 fa[2][4], fb[2][4];
#define KV_LOAD(s_, n_) do { _Pragma("unroll") for (int ks = 0; ks < 4; ++ks) { fa[s_][ks] = *(const bf16x8*)(ka + ((n_) * 4 + ks) * 4096); fb[s_][ks] = *(const LAS bf16x8*)(lds + ((n_) * 4 + ks) * 1024 + (lr * 4 + q4) * 16); } } while (0)
#define KV_STEP(s_, n_) do { f32x4 kv = {0.f, 0.f, 0.f, 0.f}; \
        _Pragma("unroll") for (int ks = 0; ks < 4; ++ks) kv = __builtin_amdgcn_mfma_f32_16x16x32_bf16(fa[s_][ks], fb[s_][ks], kv, 0, 0, 0); \
        u32x2 wv; wv.x = cvt_pk_bf16(S[0], S[1]); wv.y = cvt_pk_bf16(S[2], S[3]); \
        *(u32x2*)(SPT + ((size_t)((((((b * 16 + (n_)) * 4 + h) * 8 + es) * 4 + (wave >> 1)) * 64) + (((2 * wave + (q4 >> 1)) & 3) * 16 + lr))) * 8 + 4 * (q4 & 1)) = wv; \
        S = S * g128 + kv; } while (0)
    KV_LOAD(0, 0);
#pragma unroll
    for (int n = 0; n < 16; n += 2) {
        KV_LOAD(1, n + 1);
        __builtin_amdgcn_sched_barrier(0);
        KV_STEP(0, n);
        __builtin_amdgcn_sched_barrier(0);
        if (n + 2 < 16) KV_LOAD(0, n + 2);
        __builtin_amdgcn_sched_barrier(0);
        KV_STEP(1, n + 1);
        __builtin_amdgcn_sched_barrier(0);
    }
#undef KV_LOAD
#undef KV_STEP
    float* rp = p.out + OUT_RETP + ((size_t)((l * NB + b) * 4 + h)) * 16384;
#pragma unroll
    for (int r = 0; r < 4; ++r) rp[(d0 + r) * 128 + e] = S[r];
    __syncthreads();
}

__device__ void rs_task(const Params& p_, int l, int task, LAS unsigned char* lds) {
    const Params p = gp(p_);
    unsigned char* const wsb = ows(p.ws);
    const int tid = otid(), w = __builtin_amdgcn_readfirstlane(tid >> 6), lane = tid & 63, q4 = lane >> 4, lr = lane & 15, b = task >> 2, h = task & 3;
    const bf16_t* ZB = (const bf16_t*)(wsb + WS_ZB); bf16_t* MIX = (bf16_t*)(wsb + WS_MIX);
    LAS float* qT = (LAS float*)lds;
    LAS float* kT = qT + 1024;
    LAS float* kdT = kT + 1024;
    LAS float* vS = kdT + 1024;
    LAS float* sc = vS + 1024;
    LAS float* red = sc + 64;
    LAS float* uF = red + 16 * 8 * 128;
    LAS float* mS = uF + 23 * 128;
    const float lg = lg2gamma(h);
    const size_t r0 = (size_t)NP + b * 8;
    const int g = h, win = 2 << g;
    const float* S0 = p.state_ret + ((size_t)((l * SB + b) * 4 + h)) * 16384;
    float* S1 = p.out + OUT_RETS + ((size_t)((l * SB + b) * 4 + h)) * 16384;
    const int e4 = (tid & 31) * 4, dg = tid >> 5;
    f32x4 s0[8];
#pragma unroll
    for (int dd = 0; dd < 8; ++dd) s0[dd] = __builtin_nontemporal_load((const f32x4*)(S0 + (dg * 8 + dd) * 128 + e4));
    const int li = tid >> 6, ld2 = (tid & 63) * 2;
    const unsigned qv = __builtin_nontemporal_load((const unsigned*)(ZB + (r0 + li) * DIN + 512 + h * 128 + ld2)), kv = __builtin_nontemporal_load((const unsigned*)(ZB + (r0 + li) * DIN + 1024 + h * 128 + ld2)), vv = __builtin_nontemporal_load((const unsigned*)(ZB + (r0 + li) * DIN + 1536 + h * 128 + ld2));
    f32x4 hist = {0.f, 0.f, 0.f, 0.f}; u32x2 ucur = {0u, 0u};
    if (tid < 480) hist = __builtin_nontemporal_load((const f32x4*)(p.state_pool + ((size_t)(l * SB + b) * 15 + (tid >> 5)) * 512 + g * 128 + (tid & 31) * 4));
    if (tid < 256) ucur = *(const u32x2*)(ZB + (r0 + (tid >> 5)) * DIN + g * 128 + (tid & 31) * 4);
    const bf16_t gr0 = ZB[(r0 + li) * DIN + 2560 + h * 128 + lane], gr1 = ZB[(r0 + li) * DIN + 2560 + h * 128 + lane + 64];
    const bf16_t* WpT = (const bf16_t*)(wsb + WS_WPOOL) + (size_t)(l * 4 + g) * 16384;
    bf16x8 wf[4];
#pragma unroll
    for (int ks = 0; ks < 4; ++ks) wf[ks] = *(const bf16x8*)(WpT + (size_t)(16 * w + lr) * 128 + ks * 32 + 8 * q4);
    const int pcol = g * 128 + 16 * w + 4 * q4;
    const f32x4 psc = *(const f32x4*)(p.pool_scale + l * 512 + pcol);
    u32x2 gpq = {0u, 0u}; if (lr < 8) gpq = *(const u32x2*)(ZB + (r0 + lr) * DIN + 2048 + pcol);
    float cp[7];
    if (h == 0) {
#pragma unroll
        for (int k = 0; k < 7; ++k) cp[k] = p.state_pool[((size_t)(l * SB + b) * 15 + 8) * 512 + tid + k * NTHREADS];
    }
    __builtin_amdgcn_sched_barrier(0);
    { const float kd = fexp2((float)(7 - li) * lg);
      qT[ld2 * 8 + li] = __uint_as_float(qv << 16); qT[(ld2 + 1) * 8 + li] = __uint_as_float(qv & 0xffff0000u);
      const float k0 = __uint_as_float(kv << 16), k1 = __uint_as_float(kv & 0xffff0000u);
      kT[ld2 * 8 + li] = k0; kT[(ld2 + 1) * 8 + li] = k1; kdT[ld2 * 8 + li] = k0 * kd; kdT[(ld2 + 1) * 8 + li] = k1 * kd;
      vS[li * 128 + ld2] = __uint_as_float(vv << 16); vS[li * 128 + ld2 + 1] = __uint_as_float(vv & 0xffff0000u);
      if (tid < 480) *(LAS f32x4*)(uF + (tid >> 5) * 128 + (tid & 31) * 4) = hist;
      if (tid < 256) *(LAS f32x4*)(uF + (15 + (tid >> 5)) * 128 + (tid & 31) * 4) = (f32x4){__uint_as_float(ucur.x << 16), __uint_as_float(ucur.x & 0xffff0000u), __uint_as_float(ucur.y << 16), __uint_as_float(ucur.y & 0xffff0000u)};
      mS[1024 + tid] = 0.f; mS[1536 + tid] = 0.f; }
    __syncthreads();
    {
      const int pr = tid >> 3, i = pr >> 3, j = pr & 7, dp = tid & 7; float sv = 0.f;
#pragma unroll
      for (int d = dp * 16; d < dp * 16 + 16; ++d) sv += qT[d * 8 + i] * kT[d * 8 + j];
      sv += __shfl_xor(sv, 1); sv += __shfl_xor(sv, 2); sv += __shfl_xor(sv, 4);
      if (dp == 0) sc[pr] = (j <= i) ? sv * fexp2((float)(i - j) * lg) : 0.f; }
    {
      const int c = tid & 127, tq = tid >> 7; const float rw = 1.0f / (float)win;
#pragma unroll
      for (int k2 = 0; k2 < 2; ++k2) { const int ts = 2 * tq + k2; float sm = 0.f;
          for (int k = 0; k < win; ++k) sm += uF[(15 + ts - k) * 128 + c];
          mS[ts * 128 + c] = sm * rw - uF[(15 + ts) * 128 + c]; } }
    {
        const float g8 = fexp2(8.0f * lg);
        f32x4 cr[8], vj[8];
#pragma unroll
        for (int i = 0; i < 8; ++i) { cr[i] = (f32x4){0.f, 0.f, 0.f, 0.f}; vj[i] = *(const LAS f32x4*)(vS + i * 128 + e4); }
#pragma unroll
        for (int dd = 0; dd < 8; ++dd) { const int d = dg * 8 + dd;
            const f32x4 qa = *(const LAS f32x4*)(qT + d * 8), qb = *(const LAS f32x4*)(qT + d * 8 + 4), ka = *(const LAS f32x4*)(kdT + d * 8), kb = *(const LAS f32x4*)(kdT + d * 8 + 4);
            f32x4 sf = s0[dd] * g8;
#pragma unroll
            for (int i = 0; i < 4; ++i) { cr[i] += s0[dd] * qa[i]; cr[4 + i] += s0[dd] * qb[i]; sf += vj[i] * ka[i]; sf += vj[4 + i] * kb[i]; }
            __builtin_nontemporal_store(sf, (f32x4*)(S1 + d * 128 + e4)); }
#pragma unroll
        for (int i = 0; i < 8; ++i) *(LAS f32x4*)(red + (dg * 8 + i) * 128 + e4) = cr[i];
    }
    __syncthreads();
    { const int i = li; float o[2]; float ss = 0.f;
#pragma unroll
      for (int k = 0; k < 2; ++k) { const int e = lane + 64 * k;
          float cross = 0.f;
#pragma unroll
          for (int d2 = 0; d2 < 16; ++d2) cross += red[(d2 * 8 + i) * 128 + e];
          float v = fexp2((float)(i + 1) * lg) * cross;
#pragma unroll
          for (int j = 0; j < 8; ++j) v += sc[i * 8 + j] * vS[j * 128 + e];
          o[k] = v; ss += v * v; }
      ss = wave_sum(ss); const float rstd = rsqrtf(ss * (1.0f / 128.0f) + EPSN);
      MIX[(r0 + i) * DM + 512 + h * 128 + lane] = f2bf(o[0] * rstd * silu_f(bf2f(gr0)));
      MIX[(r0 + i) * DM + 512 + h * 128 + lane + 64] = f2bf(o[1] * rstd * silu_f(bf2f(gr1))); }
    {
        f32x4 acc = {0.f, 0.f, 0.f, 0.f};
#pragma unroll
        for (int ks = 0; ks < 4; ++ks) { const f32x4 m0 = *(const LAS f32x4*)(mS + lr * 128 + ks * 32 + 8 * q4), m1 = *(const LAS f32x4*)(mS + lr * 128 + ks * 32 + 8 * q4 + 4);
            const bf16x8 mf = __builtin_bit_cast(bf16x8, (u32x4){cvt_pk_bf16(m0[0], m0[1]), cvt_pk_bf16(m0[2], m0[3]), cvt_pk_bf16(m1[0], m1[1]), cvt_pk_bf16(m1[2], m1[3])});
            acc = __builtin_amdgcn_mfma_f32_16x16x32_bf16(wf[ks], mf, acc, 0, 0, 0); }
        if (lr < 8) { const float g0 = __uint_as_float(gpq.x << 16), g1 = __uint_as_float(gpq.x & 0xffff0000u), g2 = __uint_as_float(gpq.y << 16), g3 = __uint_as_float(gpq.y & 0xffff0000u);
            u32x2 o; o.x = cvt_pk_bf16(acc[0] * psc[0] * silu_f(g0), acc[1] * psc[1] * silu_f(g1)); o.y = cvt_pk_bf16(acc[2] * psc[2] * silu_f(g2), acc[3] * psc[3] * silu_f(g3));
            *(u32x2*)(MIX + (r0 + lr) * DM + pcol) = o; }
    }
    if (h == 0) {
        float* dp = p.out + OUT_POOLS + ((size_t)(l * SB + b) * 15) * 512;
#pragma unroll
        for (int k = 0; k < 7; ++k) dp[tid + k * NTHREADS] = cp[k];
    }
    __syncthreads();
}

template <int NPAIR>
__device__ __forceinline__ void retention_part(const Params& p_, int R0, int w, int q4, int lr) {
    const Params p = gp(p_);
    unsigned char* const wsb = ows(p.ws);
    const int lane = q4 * 16 + lr;
    const bf16_t* QF = (const bf16_t*)(wsb + WS_QF); const bf16_t* KF = (const bf16_t*)(wsb + WS_KF);
    const bf16_t* G2 = (const bf16_t*)(wsb + WS_G2); bf16_t* MIX = (bf16_t*)(wsb + WS_MIX);
    const bf16_t* VT = (const bf16_t*)(wsb + WS_VT); const bf16_t* SPT = (const bf16_t*)(wsb + WS_SPT);
    const int h = w >> 1, itb = 2 * (w & 1), b = R0 >> 11, n = (R0 & 2047) >> 7, itg0 = 4 * (NPAIR / 2 - 1) + itb;
    const size_t t0 = (size_t)(R0 & ~127);
    const float lg = lg2gamma(h);
    bf16x8 qf[2][4];
#pragma unroll
    for (int i2 = 0; i2 < 2; ++i2) { const bf16_t* qp = QF + ((size_t)((((R0 >> 4) + itb + i2) * 4 + h) * 4) * 64 + lane) * 8;
#pragma unroll
        for (int ks = 0; ks < 4; ++ks) qf[i2][ks] = __builtin_nontemporal_load((const bf16x8*)(qp + ks * 512)); }
    f32x4 acc[2][8];
#pragma unroll
    for (int i2 = 0; i2 < 2; ++i2)
#pragma unroll
        for (int et = 0; et < 8; ++et) acc[i2][et] = (f32x4){0.f, 0.f, 0.f, 0.f};
#pragma unroll
    for (int eq = 0; eq < 4; ++eq) {
        bf16x8 sf[2][4];
#pragma unroll
        for (int e2 = 0; e2 < 2; ++e2) { const bf16_t* sp = SPT + ((size_t)(((((b * 16 + n) * 4 + h) * 8 + eq * 2 + e2) * 4) * 64) + lane) * 8;
#pragma unroll
            for (int ks = 0; ks < 4; ++ks) sf[e2][ks] = *(const bf16x8*)(sp + ks * 512); }
        __builtin_amdgcn_sched_barrier(0);
#pragma unroll
        for (int e2 = 0; e2 < 2; ++e2)
#pragma unroll
            for (int ks = 0; ks < 4; ++ks) {
                acc[0][eq * 2 + e2] = __builtin_amdgcn_mfma_f32_16x16x32_bf16(sf[e2][ks], qf[0][ks], acc[0][eq * 2 + e2], 0, 0, 0);
                acc[1][eq * 2 + e2] = __builtin_amdgcn_mfma_f32_16x16x32_bf16(sf[e2][ks], qf[1][ks], acc[1][eq * 2 + e2], 0, 0, 0); }
    }
#pragma unroll
    for (int i2 = 0; i2 < 2; ++i2) { const float dec = fexp2((float)(16 * (itg0 + i2) + lr + 1) * lg);
#pragma unroll
        for (int et = 0; et < 8; ++et) acc[i2][et] *= dec; }
#pragma unroll
    for (int jp = 0; jp < NPAIR; ++jp) {
        if (2 * jp <= itg0 + 1) {
            bf16x8 kf[2][4], vf[8];
#pragma unroll
            for (int hf = 0; hf < 2; ++hf) { const bf16_t* kp = KF + ((size_t)((((t0 >> 4) + 2 * jp + hf) * 4 + h) * 4) * 64 + lane) * 8;
#pragma unroll
                for (int ks = 0; ks < 4; ++ks) kf[hf][ks] = *(const bf16x8*)(kp + ks * 512); }
#pragma unroll
            for (int et = 0; et < 8; ++et) vf[et] = *(const bf16x8*)(VT + ((size_t)((((b * 4 + h) * 16 + n) * 4 + jp) * 128 + 16 * et + lr)) * 32 + 8 * q4);
            __builtin_amdgcn_sched_barrier(0);
#pragma unroll
            for (int i2 = 0; i2 < 2; ++i2) {
                const int itg = itg0 + i2;
                if (2 * jp <= itg) {
                    unsigned pw[4];
#pragma unroll
                    for (int hf = 0; hf < 2; ++hf) {
                        f32x4 sacc = {0.f, 0.f, 0.f, 0.f};
#pragma unroll
                        for (int ks = 0; ks < 4; ++ks) sacc = __builtin_amdgcn_mfma_f32_16x16x32_bf16(kf[hf][ks], qf[i2][ks], sacc, 0, 0, 0);
                        float pv[4];
#pragma unroll
                        for (int r = 0; r < 4; ++r) { const int diff = (16 * itg + lr) - (16 * (2 * jp + hf) + 4 * q4 + r); pv[r] = (diff >= 0) ? sacc[r] * fexp2((float)diff * lg) : 0.f; }
                        pw[2 * hf] = cvt_pk_bf16(pv[0], pv[1]); pw[2 * hf + 1] = cvt_pk_bf16(pv[2], pv[3]);
                    }
                    const bf16x8 P = __builtin_bit_cast(bf16x8, (u32x4){pw[0], pw[1], pw[2], pw[3]});
#pragma unroll
                    for (int et = 0; et < 8; ++et) acc[i2][et] = __builtin_amdgcn_mfma_f32_16x16x32_bf16(vf[et], P, acc[i2][et], 0, 0, 0);
                }
            }
        }
    }
#pragma unroll
    for (int i2 = 0; i2 < 2; ++i2) {
        const size_t row = (size_t)R0 + 16 * (itb + i2) + lr;
        u32x2 gqv[8];
#pragma unroll
        for (int et = 0; et < 8; ++et) gqv[et] = __builtin_nontemporal_load((const u32x2*)(G2 + g2_index(row, 512 + h * 128 + 16 * et + 4 * q4)));
        float ss = 0.f;
#pragma unroll
        for (int et = 0; et < 8; ++et)
#pragma unroll
            for (int r = 0; r < 4; ++r) ss += acc[i2][et][r] * acc[i2][et][r];
        ss += __shfl_xor(ss, 16); ss += __shfl_xor(ss, 32);
        const float rstd = rsqrtf(ss * (1.0f / 128.0f) + EPSN);
#pragma unroll
        for (int et = 0; et < 8; ++et) { const int col = 512 + h * 128 + 16 * et + 4 * q4;
            const u32x2 gg = gqv[et];
            const float g0 = __uint_as_float(gg.x << 16), g1 = __uint_as_float(gg.x & 0xffff0000u), g2 = __uint_as_float(gg.y << 16), g3 = __uint_as_float(gg.y & 0xffff0000u);
            u32x2 o; o.x = cvt_pk_bf16(acc[i2][et][0] * rstd * silu_f(g0), acc[i2][et][1] * rstd * silu_f(g1)); o.y = cvt_pk_bf16(acc[i2][et][2] * rstd * silu_f(g2), acc[i2][et][3] * rstd * silu_f(g3));
            *(u32x2*)(MIX + mixf_index(row, col)) = o; }
    }
}

__device__ void mixer_task(const Params& p_, int l, int tile, LAS unsigned char* lds) {
    const Params p = gp(p_);
    unsigned char* const wsb = ows(p.ws);
    const int tid = otid(), w = __builtin_amdgcn_readfirstlane(tid >> 6), lane = tid & 63, q4 = lane >> 4, lr = lane & 15;
    const int R0 = tile * 64;
    const bf16_t* ZB = (const bf16_t*)(wsb + WS_ZB); bf16_t* MIX = (bf16_t*)(wsb + WS_MIX);
    LAS bf16_t* U = (LAS bf16_t*)lds;
    LAS bf16_t* Mm = (LAS bf16_t*)(lds + 80896);
    {
        const int tl0 = R0 & 2047;
        u32x4 v[10];
#pragma unroll
        for (int k = 0; k < 10; ++k) { const int idx = tid + k * NTHREADS, rr = idx >> 6, c8 = (idx & 63) * 8;
            v[k] = (u32x4){0u, 0u, 0u, 0u};
            if (idx < 79 * 64 && tl0 - 15 + rr >= 0) v[k] = __builtin_nontemporal_load((const u32x4*)(ZB + (size_t)(R0 - 15 + rr) * DIN + c8)); }
#pragma unroll
        for (int k = 0; k < 10; ++k) { const int idx = tid + k * NTHREADS, rr = idx >> 6, c8 = (idx & 63) * 8;
            if (idx < 79 * 64) *(LAS u32x4*)(U + rr * 512 + c8) = v[k]; }
        __syncthreads();
        const int c = tid, win = 2 << (c >> 7);
        float s = 0.f;
        for (int k = 1; k < win; ++k) s += bf2f(U[(15 - k) * 512 + c]);
#pragma unroll 8
        for (int ii = 0; ii < 64; ++ii) { const int tl = tl0 + ii;
            const float cur = bf2f(U[(15 + ii) * 512 + c]); s += cur;
            const int cnt = (tl + 1 < win) ? (tl + 1) : win;
            Mm[ii * 520 + c] = f2bf(s * __builtin_amdgcn_rcpf((float)cnt) - cur);
            s -= bf2f(U[(15 + ii - (win - 1)) * 512 + c]); }
        __syncthreads();
        const int g = w >> 1;
        const bf16_t* WpT = (const bf16_t*)(wsb + WS_WPOOL) + (size_t)(l * 4 + g) * 16384;
        bf16x8 af[2][4];
#pragma unroll
        for (int m2 = 0; m2 < 2; ++m2)
#pragma unroll
            for (int ks = 0; ks < 4; ++ks) af[m2][ks] = *(const LAS bf16x8*)(Mm + (16 * (2 * (w & 1) + m2) + lr) * 520 + g * 128 + ks * 32 + 8 * q4);
#pragma unroll
        for (int nh = 0; nh < 2; ++nh) {
            bf16x8 bfr[4][4]; u32x2 gq[2][4]; f32x4 psc[4];
#pragma unroll
            for (int n2 = 0; n2 < 4; ++n2) { const bf16_t* bp = WpT + (size_t)(16 * (nh * 4 + n2) + lr) * 128 + 8 * q4;
#pragma unroll
                for (int ks = 0; ks < 4; ++ks) bfr[n2][ks] = *(const bf16x8*)(bp + ks * 32);
                const int col = g * 128 + 16 * (nh * 4 + n2) + 4 * q4;
                psc[n2] = *(const f32x4*)(p.pool_scale + l * 512 + col);
#pragma unroll
                for (int m2 = 0; m2 < 2; ++m2) gq[m2][n2] = __builtin_nontemporal_load((const u32x2*)((const bf16_t*)(wsb + WS_G2) + g2_index((size_t)R0 + 16 * (2 * (w & 1) + m2) + lr, col))); }
            __builtin_amdgcn_sched_barrier(0);
#pragma unroll
            for (int m2 = 0; m2 < 2; ++m2)
#pragma unroll
                for (int n2 = 0; n2 < 4; ++n2) {
                    f32x4 acc = {0.f, 0.f, 0.f, 0.f};
#pragma unroll
                    for (int ks = 0; ks < 4; ++ks) acc = __builtin_amdgcn_mfma_f32_16x16x32_bf16(bfr[n2][ks], af[m2][ks], acc, 0, 0, 0);
                    const size_t row = (size_t)R0 + 16 * (2 * (w & 1) + m2) + lr; const int col = g * 128 + 16 * (nh * 4 + n2) + 4 * q4;
                    const u32x2 gg = gq[m2][n2];
                    const float g0 = __uint_as_float(gg.x << 16), g1 = __uint_as_float(gg.x & 0xffff0000u), g2 = __uint_as_float(gg.y << 16), g3 = __uint_as_float(gg.y & 0xffff0000u);
                    u32x2 o; o.x = cvt_pk_bf16(acc[0] * psc[n2][0] * silu_f(g0), acc[1] * psc[n2][1] * silu_f(g1)); o.y = cvt_pk_bf16(acc[2] * psc[n2][2] * silu_f(g2), acc[3] * psc[n2][3] * silu_f(g3));
                    *(u32x2*)(MIX + mixf_index(row, col)) = o;
                }
        }
        __syncthreads();
    }
    if ((R0 >> 6) & 1) retention_part<4>(p, R0, w, q4, lr); else retention_part<2>(p, R0, w, q4, lr);
}

__device__ void mini_gemm_task(const Params& p_, int l, int t, LAS unsigned char* lds) {
    const Params p = gp(p_);
    unsigned char* const wsb = ows(p.ws);
    const int tid = otid(), w = __builtin_amdgcn_readfirstlane(tid >> 6), lane = tid & 63, q4 = lane >> 4, lr = lane & 15;
    const int tm = t >> 4, tn = t & 15, mp = w & 1, nh = (w >> 1) & 1, kh = w >> 2;
    constexpr int MGP = 2048 + 64;
    LAS unsigned char* const As = lds + 16384;
    {
        const bf16_t* src = (const bf16_t*)(wsb + WS_MIX) + ((size_t)NP + 64 * tm) * DM;
        u32x4 vv[16];
#pragma unroll
        for (int k = 0; k < 16; ++k) { const int pi = tid + k * NTHREADS; vv[k] = *(const u32x4*)(src + (size_t)(pi >> 7) * DM + (pi & 127) * 8); }
#pragma unroll
        for (int k = 0; k < 16; ++k) { const int pi = tid + k * NTHREADS; *(LAS u32x4*)(As + (pi >> 7) * MGP + (pi & 127) * 16) = vv[k]; }
        __syncthreads();
    }
    const LAS unsigned char* ap0 = As + (32 * mp + lr) * MGP + (512 * kh + 8 * q4) * 2;
    const LAS unsigned char* ap1 = ap0 + 16 * MGP;
    const bf16_t* bp0 = (const bf16_t*)(wsb + WS_WO) + (size_t)l * DM * DM + ((size_t)((tn * 4 + 2 * nh) * 32 + 16 * kh) * 64 + lane) * 8;
    const bf16_t* bp1 = bp0 + 32 * 512;
    f32x4 acc[2][2];
#pragma unroll
    for (int i = 0; i < 2; ++i)
#pragma unroll
        for (int j = 0; j < 2; ++j) acc[i][j] = (f32x4){0.f, 0.f, 0.f, 0.f};
    bf16x8 fa0[2][4], fa1[2][4], fb0[2][4], fb1[2][4];
#define MG_LOAD(s_, kb) do { _Pragma("unroll") for (int k = 0; k < 4; ++k) { fa0[s_][k] = *(const LAS bf16x8*)(ap0 + ((kb) * 4 + k) * 64); fa1[s_][k] = *(const LAS bf16x8*)(ap1 + ((kb) * 4 + k) * 64); \
        fb0[s_][k] = *(const bf16x8*)(bp0 + ((kb) * 4 + k) * 512); fb1[s_][k] = *(const bf16x8*)(bp1 + ((kb) * 4 + k) * 512); } } while (0)
#define MG_MMA(s_) do { _Pragma("unroll") for (int k = 0; k < 4; ++k) { \
        acc[0][0] = __builtin_amdgcn_mfma_f32_16x16x32_bf16(fb0[s_][k], fa0[s_][k], acc[0][0], 0, 0, 0); acc[0][1] = __builtin_amdgcn_mfma_f32_16x16x32_bf16(fb1[s_][k], fa0[s_][k], acc[0][1], 0, 0, 0); \
        acc[1][0] = __builtin_amdgcn_mfma_f32_16x16x32_bf16(fb0[s_][k], fa1[s_][k], acc[1][0], 0, 0, 0); acc[1][1] = __builtin_amdgcn_mfma_f32_16x16x32_bf16(fb1[s_][k], fa1[s_][k], acc[1][1], 0, 0, 0); } } while (0)
    MG_LOAD(0, 0);
#pragma unroll
    for (int kb = 0; kb < 4; kb += 2) {
        MG_LOAD(1, kb + 1);
        __builtin_amdgcn_sched_barrier(0);
        MG_MMA(0);
        __builtin_amdgcn_sched_barrier(0);
        if (kb + 2 < 4) MG_LOAD(0, kb + 2);
        __builtin_amdgcn_sched_barrier(0);
        MG_MMA(1);
        __builtin_amdgcn_sched_barrier(0);
    }
#undef MG_LOAD
#undef MG_MMA
    LAS f32x4* red = (LAS f32x4*)lds;
    if (kh == 1) {
#pragma unroll
        for (int i = 0; i < 2; ++i)
#pragma unroll
            for (int j = 0; j < 2; ++j) red[((w & 3) * 4 + i * 2 + j) * 64 + lane] = acc[i][j];
    }
    __syncthreads();
    if (kh == 0) {
#pragma unroll
        for (int i = 0; i < 2; ++i) {
            float* yp = (float*)(wsb + WS_Y) + ((size_t)NP + 64 * tm + 32 * mp + 16 * i + lr) * DM + 64 * tn + 32 * nh + 4 * q4;
            *(f32x4*)yp = acc[i][0] + red[((w & 3) * 4 + i * 2 + 0) * 64 + lane]; *(f32x4*)(yp + 16) = acc[i][1] + red[((w & 3) * 4 + i * 2 + 1) * 64 + lane];
        }
    }
    __syncthreads();
}

__device__ void inproj_s_task(const Params& p_, int l, int t, LAS unsigned char* lds, bool stage_a) {
    const Params p = gp(p_);
    unsigned char* const wsb = ows(p.ws);
    const int tid = otid(), w = __builtin_amdgcn_readfirstlane(tid >> 6), lane = tid & 63, q4 = lane >> 4, lr = lane & 15;
    const int tm = t / 24, sn = t % 24, jn = w & 3, kh = w >> 2;
    LAS unsigned char* const As = lds + 32768;
    if (stage_a) {
        const bf16_t* src = (const bf16_t*)(wsb + WS_HSF) + (size_t)(2 * tm) * 32 * 512;
        u32x4 vv[8];
#pragma unroll
        for (int k = 0; k < 8; ++k) vv[k] = *(const u32x4*)(src + (size_t)(tid + k * NTHREADS) * 8);
#pragma unroll
        for (int k = 0; k < 8; ++k) *(LAS u32x4*)(As + (tid + k * NTHREADS) * 16) = vv[k];
        __syncthreads();
    }
    const LAS unsigned char* ap0 = As + (16 * kh) * 1024 + lane * 16;
    const LAS unsigned char* ap1 = ap0 + 32 * 1024;
    const bf16_t* bp0 = (const bf16_t*)(wsb + WS_WINF) + (size_t)l * DIN * DM + ((size_t)((sn * 8 + jn) * 32 + 16 * kh) * 64 + lane) * 8;
    const bf16_t* bp1 = bp0 + (size_t)4 * 32 * 512;
    f32x4 acc[2][2];
#pragma unroll
    for (int i = 0; i < 2; ++i)
#pragma unroll
        for (int j = 0; j < 2; ++j) acc[i][j] = (f32x4){0.f, 0.f, 0.f, 0.f};
    bf16x8 fa0[2][4], fa1[2][4], fb0[2][4], fb1[2][4];
#define IS_LOAD(s_, kb) do { _Pragma("unroll") for (int k = 0; k < 4; ++k) { fa0[s_][k] = *(const LAS bf16x8*)(ap0 + ((kb) * 4 + k) * 1024); fa1[s_][k] = *(const LAS bf16x8*)(ap1 + ((kb) * 4 + k) * 1024); \
        fb0[s_][k] = *(const bf16x8*)(bp0 + ((kb) * 4 + k) * 512); fb1[s_][k] = *(const bf16x8*)(bp1 + ((kb) * 4 + k) * 512); } } while (0)
#define IS_MMA(s_) do { _Pragma("unroll") for (int k = 0; k < 4; ++k) { \
        acc[0][0] = __builtin_amdgcn_mfma_f32_16x16x32_bf16(fb0[s_][k], fa0[s_][k], acc[0][0], 0, 0, 0); acc[0][1] = __builtin_amdgcn_mfma_f32_16x16x32_bf16(fb1[s_][k], fa0[s_][k], acc[0][1], 0, 0, 0); \
        acc[1][0] = __builtin_amdgcn_mfma_f32_16x16x32_bf16(fb0[s_][k], fa1[s_][k], acc[1][0], 0, 0, 0); acc[1][1] = __builtin_amdgcn_mfma_f32_16x16x32_bf16(fb1[s_][k], fa1[s_][k], acc[1][1], 0, 0, 0); } } while (0)
    IS_LOAD(0, 0);
#pragma unroll
    for (int kb = 0; kb < 4; kb += 2) {
        IS_LOAD(1, kb + 1);
        __builtin_amdgcn_sched_barrier(0);
        IS_MMA(0);
        __builtin_amdgcn_sched_barrier(0);
        if (kb + 2 < 4) IS_LOAD(0, kb + 2);
        __builtin_amdgcn_sched_barrier(0);
        IS_MMA(1);
        __builtin_amdgcn_sched_barrier(0);
    }
#undef IS_LOAD
#undef IS_MMA
    LAS f32x4* red = (LAS f32x4*)lds;
    if (kh == 1) {
#pragma unroll
        for (int i = 0; i < 2; ++i)
#pragma unroll
            for (int j = 0; j < 2; ++j) red[(jn * 4 + i * 2 + j) * 64 + lane] = acc[i][j];
    }
    __syncthreads();
    if (kh == 0) {
#pragma unroll
        for (int mt = 0; mt < 2; ++mt) {
            const int rs = 32 * tm + 16 * mt + lr, row = NP + rs, colb = 128 * sn, d0 = 16 * jn + 4 * q4;
            f32x4 v0 = acc[mt][0] + red[(jn * 4 + mt * 2 + 0) * 64 + lane], v1 = acc[mt][1] + red[(jn * 4 + mt * 2 + 1) * 64 + lane];
            if (sn >= 4 && sn < 12) {
                const int tpos = 2048 + (rs & 7);
                const f32x4 c4 = *(const f32x4*)((const float*)(wsb + WS_COS) + tpos * 64 + d0), s4 = *(const f32x4*)((const float*)(wsb + WS_SIN) + tpos * 64 + d0);
                f32x4 r0 = v0 * c4 - v1 * s4, r1 = v0 * s4 + v1 * c4;
                if (sn >= 8) { r0 *= 0.08838834764831845f; r1 *= 0.08838834764831845f; }
                v0 = r0; v1 = r1;
            }
            u32x2 w0, w1; w0.x = cvt_pk_bf16(v0[0], v0[1]); w0.y = cvt_pk_bf16(v0[2], v0[3]); w1.x = cvt_pk_bf16(v1[0], v1[1]); w1.y = cvt_pk_bf16(v1[2], v1[3]);
            bf16_t* zp = (bf16_t*)(wsb + WS_ZB) + (size_t)row * DIN + colb + d0;
            *(u32x2*)zp = w0; *(u32x2*)(zp + 64) = w1;
            if (sn < 4) { float* pp = p.out + OUT_POOLS + (size_t)l * SB * 15 * 512 + ((size_t)((rs >> 3) * 15 + 7 + (rs & 7))) * 512 + colb + d0; *(f32x4*)pp = v0; *(f32x4*)(pp + 64) = v1; }
        }
    }
    __syncthreads();
}

__device__ void fusedp_task(const Params& p_, int l, int tile, LAS unsigned char* lds) {
    const Params p = gp(p_);
    unsigned char* const wsb = ows(p.ws);
    const int tid = otid(), w = __builtin_amdgcn_readfirstlane(tid >> 6), lane = tid & 63, q4 = lane >> 4, lr = lane & 15;
    const int R0 = tile * 64, brow = R0 >> 11;
    const bf16_t* MIX = (const bf16_t*)(wsb + WS_MIX); const bf16_t* WoT = (const bf16_t*)(wsb + WS_WO) + (size_t)l * DM * DM;
    const float* mod = (const float*)(wsb + WS_MOD); float* XR = (float*)(wsb + WS_XR); bf16_t* H = (bf16_t*)(wsb + WS_H);
    const bf16_t* bp = WoT + ((size_t)(w * 8) * 32 * 64 + lane) * 8;
    bf16x8 B0[8], B1[8];
#define FP_LOADB(dst, kk) do { _Pragma("unroll") for (int nt = 0; nt < 8; ++nt) dst[nt] = *(const bf16x8*)(bp + (size_t)(nt * 32 + (kk)) * 512); } while (0)
    FP_LOADB(B0, 0);
    LAS unsigned char* At = lds;
    {
        const bf16_t* src = MIX + (size_t)(R0 >> 4) * 32 * 512;
        u32x4 v[16];
#pragma unroll
        for (int k = 0; k < 16; ++k) v[k] = __builtin_nontemporal_load((const u32x4*)(src + (size_t)(tid + k * NTHREADS) * 8));
#pragma unroll
        for (int k = 0; k < 16; ++k) *(LAS u32x4*)(At + (tid + k * NTHREADS) * 16) = v[k];
    }
    __syncthreads();
    f32x4 acc[4][8];
#pragma unroll
    for (int mt = 0; mt < 4; ++mt)
#pragma unroll
        for (int nt = 0; nt < 8; ++nt) acc[mt][nt] = (f32x4){0.f, 0.f, 0.f, 0.f};
#define FP_STEP(Bx, kk) do { bf16x8 Af[4]; \
        _Pragma("unroll") for (int mt = 0; mt < 4; ++mt) Af[mt] = *(const LAS bf16x8*)(At + (mt * 32 + (kk)) * 1024 + lane * 16); \
        __builtin_amdgcn_s_setprio(1); \
        _Pragma("unroll") for (int mt = 0; mt < 4; ++mt) _Pragma("unroll") for (int nt = 0; nt < 8; ++nt) acc[mt][nt] = __builtin_amdgcn_mfma_f32_16x16x32_bf16(Bx[nt], Af[mt], acc[mt][nt], 0, 0, 0); \
        __builtin_amdgcn_s_setprio(0); } while (0)
#pragma unroll 1
    for (int ks = 0; ks < 32; ks += 2) {
        FP_LOADB(B1, ks + 1);
        __builtin_amdgcn_sched_barrier(0);
        FP_STEP(B0, ks);
        __builtin_amdgcn_sched_barrier(0);
        { const int kn = ks + 2 < 32 ? ks + 2 : 31; FP_LOADB(B0, kn); }
        __builtin_amdgcn_sched_barrier(0);
        FP_STEP(B1, ks + 1);
        __builtin_amdgcn_sched_barrier(0);
    }
#undef FP_LOADB
#undef FP_STEP
    constexpr int YP = 4096 + 64;
    const float* xin = (l == 0) ? p.x_prompt : (const float*)XR; float* xo = (l == DEPTH - 1) ? p.out : XR;
    f32x4 gg[4], aa[4], sh[4];
#pragma unroll
    for (int j = 0; j < 4; ++j) { const int col = lane * 4 + j * 256;
        gg[j] = *(const f32x4*)(mod + (size_t)brow * MODLD + l * 3072 + 2048 + col) * *(const f32x4*)(p.g_post + l * DM + col);
        if (l < DEPTH - 1) { aa[j] = *(const f32x4*)(p.g_pre + (l + 1) * DM + col) * (1.0f + *(const f32x4*)(mod + (size_t)brow * MODLD + (l + 1) * 3072 + 1024 + col));
            sh[j] = *(const f32x4*)(mod + (size_t)brow * MODLD + (l + 1) * 3072 + col); }
        else { aa[j] = (f32x4){0.f, 0.f, 0.f, 0.f}; sh[j] = (f32x4){0.f, 0.f, 0.f, 0.f}; } }
#define FP_LOADX(dst, half_, k2_) do { _Pragma("unroll") for (int k = 0; k < 2; ++k) { const size_t off_ = (size_t)(R0 + 32 * (half_) + 4 * w + 2 * (k2_) + k) * DM; \
        _Pragma("unroll") for (int j = 0; j < 4; ++j) dst[k][j] = __builtin_nontemporal_load((const f32x4*)(xin + off_ + lane * 4 + j * 256)); } } while (0)
#define FP_ROWS(xv, half_, k2_) do { _Pragma("unroll") for (int k = 0; k < 2; ++k) { const int rl = 4 * w + 2 * (k2_) + k; const size_t off = (size_t)(R0 + 32 * (half_) + rl) * DM; \
        f32x4 y[4]; float ss = 0.f; \
        _Pragma("unroll") for (int j = 0; j < 4; ++j) { y[j] = *(const LAS f32x4*)(lds + rl * YP + (lane * 4 + j * 256) * 4); ss += y[j][0] * y[j][0] + y[j][1] * y[j][1] + y[j][2] * y[j][2] + y[j][3] * y[j][3]; } \
        ss = wave_sum(ss); const float rsy = rsqrtf(ss * (1.0f / DM) + EPSN); \
        float sx = 0.f; \
        _Pragma("unroll") for (int j = 0; j < 4; ++j) { const f32x4 v = xv[k][j] + gg[j] * (y[j] * rsy); y[j] = v; __builtin_nontemporal_store(v, (f32x4*)(xo + off + lane * 4 + j * 256)); \
            sx += v[0] * v[0] + v[1] * v[1] + v[2] * v[2] + v[3] * v[3]; } \
        if (l < DEPTH - 1) { \
            sx = wave_sum(sx); const float rsx = rsqrtf(sx * (1.0f / DM) + EPSN); \
            _Pragma("unroll") for (int j = 0; j < 4; ++j) { const f32x4 hv = y[j] * rsx * aa[j] + sh[j]; \
                u32x2 o; o.x = cvt_pk_bf16(hv[0], hv[1]); o.y = cvt_pk_bf16(hv[2], hv[3]); \
                __builtin_nontemporal_store(o, (u32x2*)(H + off + lane * 4 + j * 256)); } } } } while (0)
    f32x4 xa[2][4], xb[2][4];
    FP_LOADX(xa, 0, 0);
#pragma unroll
    for (int half = 0; half < 2; ++half) {
        __syncthreads();
#pragma unroll
        for (int m2 = 0; m2 < 2; ++m2)
#pragma unroll
            for (int nt = 0; nt < 8; ++nt) *(LAS f32x4*)(lds + (16 * m2 + lr) * YP + (128 * w + 16 * nt + 4 * q4) * 4) = acc[2 * half + m2][nt];
        __syncthreads();
        FP_LOADX(xb, half, 1);
        __builtin_amdgcn_sched_barrier(0);
        FP_ROWS(xa, half, 0);
        __builtin_amdgcn_sched_barrier(0);
        if (half == 0) FP_LOADX(xa, 1, 0);
        __builtin_amdgcn_sched_barrier(0);
        FP_ROWS(xb, half, 1);
        __builtin_amdgcn_sched_barrier(0);
    }
#undef FP_LOADX
#undef FP_ROWS
    __syncthreads();
}

#define LOADP(q) Params q; { typedef void* const __attribute__((address_space(4)))* kp_t; kp_t kp_ = (kp_t)__builtin_amdgcn_kernarg_segment_ptr(); asm volatile("" : "+s"(kp_)); \
    q.x_prompt = (const float*)kp_[0]; q.x_sample = (const float*)kp_[1]; q.c_prompt = (const float*)kp_[2]; q.c_sample = (const float*)kp_[3]; q.state_ret = (const float*)kp_[4]; q.state_pool = (const float*)kp_[5]; \
    q.w_ada = (const float*)kp_[6]; q.b_ada = (const float*)kp_[7]; q.g_pre = (const float*)kp_[8]; q.g_post = (const float*)kp_[9]; q.w_in = (const float*)kp_[10]; q.w_pool = (const float*)kp_[11]; \
    q.pool_scale = (const float*)kp_[12]; q.w_o = (const float*)kp_[13]; q.out = (float*)kp_[14]; q.ws = (unsigned char*)kp_[15]; }

__global__ void __launch_bounds__(NTHREADS) fwd_megakernel(Params p_arg) {
    extern __shared__ __attribute__((aligned(16))) unsigned char lds_raw[];
    LAS unsigned char* lds = (LAS unsigned char*)lds_raw;
    cg::grid_group grid = cg::this_grid();
    const int G = gridDim.x, bx = blockIdx.x;
    volatile LAS unsigned* bst = (volatile LAS unsigned*)(lds + LDS_USER);
    if (threadIdx.x < 4) bst[threadIdx.x] = 0u;
    __syncthreads();
    const XcdBarrier xbar = xcd_barrier_post((unsigned*)(p_arg.ws + WS_BAR), bst);
#define GSYNC() xcd_barrier(xbar)

    { LOADP(p); phase_prep(p, lds); }
    grid.sync();
    {   LOADP(p);
        pg8::Gemm g{(const bf16_t*)(p.ws + WS_SC), (const bf16_t*)(p.ws + WS_WADA), 256, MODLD, DM};
        pg8::StaticOrder S; S.init(256, MODLD, G, bx);
        pg8::EpiF32 E{(float*)(p.ws + WS_MOD), MODLD, p.b_ada};
        pg8::gemm_phase<pg8::EpiF32, pg8::StaticOrder>(lds, g, S, E);
    }
    GSYNC();
    { LOADP(p); phase_rows(p, -1, 0, 0, NTOK); }
    GSYNC();
#pragma unroll 1
    for (int l = 0; l < DEPTH; ++l) {
        {   LOADP(p);
            pg8::Gemm g{(const bf16_t*)(p.ws + WS_H), (const bf16_t*)(p.ws + WS_WIN) + (size_t)l * DIN * DM, NP, DIN, DM};
            pg8::StaticOrder S; S.init(NP, DIN, G, bx);
            pg8::EpiZ E{p.ws, p.out + OUT_POOLP + (size_t)l * NB * 15 * 512, p.out + OUT_POOLS + (size_t)l * SB * 15 * 512};
            pg8::gemm_phase<pg8::EpiZ, pg8::StaticOrder>(lds, g, S, E);
        }
        { LOADP(p); int prev_tm = -1; for (int t = bx; t < 32 * 24; t += G) { const int r = t >> 8, c = t & 255, x = c & 7, i = c >> 3; inproj_s_task(p, l, i * 24 + x * 3 + r, lds, i != prev_tm); prev_tm = i; } }
        GSYNC();
        { LOADP(p); for (int t = bx; t < 256; t += G) { const int x = t & 7, i = t >> 3; kvscan_task(p, l, (x * 4 + (i >> 3)) * 8 + (i & 7), lds); } }
        { LOADP(p); for (int t = bx; t < 512; t += G) rs_task(p, l, t, lds); }
        GSYNC();
        { LOADP(p); for (int t = bx; t < NP / 64; t += G) { const int x = t & 7, i = t >> 3; mixer_task(p, l, 2 * (x * 16 + (i >> 1)) + (i & 1), lds); } }
        { LOADP(p); for (int t = bx; t < 256; t += G) { const int x = t & 7, i = t >> 3; mini_gemm_task(p, l, (i >> 1) * 16 + 2 * x + (i & 1), lds); } }
        GSYNC();
        { LOADP(p); for (int t = bx; t < NP / 64; t += G) fusedp_task(p, l, t, lds); }
        { LOADP(p); phase_rows(p, l, l + 1, NP, NTOK); }
        GSYNC();
    }
}

extern "C" void kernel_launch(void* const* d_in, const int* in_sizes, int n_in, void* d_out, int out_size, void* d_ws, size_t ws_size, hipStream_t stream) {
    static int grid_blocks = 0;
    if (grid_blocks == 0) {
        if (n_in != 14 || (size_t)out_size != OUT_END || ws_size < WS_END) { fprintf(stderr, "kernel_launch: unexpected shapes (n_in %d out %d ws %zu need %zu)\n", n_in, out_size, ws_size, (size_t)WS_END); grid_blocks = -1; return; }
        int dev = 0, cus = 0, per_cu = 0;
        (void)hipGetDevice(&dev);
        (void)hipDeviceGetAttribute(&cus, hipDeviceAttributeMultiprocessorCount, dev);
        if (hipFuncSetAttribute((const void*)fwd_megakernel, hipFuncAttributeMaxDynamicSharedMemorySize, LDS_BYTES) != hipSuccess) { fprintf(stderr, "kernel_launch: hipFuncSetAttribute failed\n"); grid_blocks = -1; return; }
        if (hipOccupancyMaxActiveBlocksPerMultiprocessor(&per_cu, (const void*)fwd_megakernel, NTHREADS, LDS_BYTES) != hipSuccess || per_cu < 1) { fprintf(stderr, "kernel_launch: occupancy query failed (%d)\n", per_cu); per_cu = 1; (void)hipGetLastError(); }
        grid_blocks = cus;
    }
    if (grid_blocks < 0) return;
    Params p{};
    p.x_prompt = (const float*)d_in[0]; p.x_sample = (const float*)d_in[1]; p.c_prompt = (const float*)d_in[2]; p.c_sample = (const float*)d_in[3];
    p.state_ret = (const float*)d_in[4]; p.state_pool = (const float*)d_in[5]; p.w_ada = (const float*)d_in[6]; p.b_ada = (const float*)d_in[7];
    p.g_pre = (const float*)d_in[8]; p.g_post = (const float*)d_in[9]; p.w_in = (const float*)d_in[10]; p.w_pool = (const float*)d_in[11];
    p.pool_scale = (const float*)d_in[12]; p.w_o = (const float*)d_in[13];
    p.out = (float*)d_out; p.ws = (unsigned char*)d_ws;
    if (hipMemsetAsync((char*)d_ws + WS_BAR, 0, XCD_BAR_WORDS * 4, stream) != hipSuccess) { fprintf(stderr, "kernel_launch: memset failed\n"); return; }
    void* args[] = {&p};
    hipError_t e = hipLaunchCooperativeKernel((const void*)fwd_megakernel, dim3(grid_blocks), dim3(NTHREADS), args, LDS_BYTES, stream);
    if (e != hipSuccess) fprintf(stderr, "cooperative launch failed: %s (grid %d)\n", hipGetErrorString(e), grid_blocks);
}
```
